# Optimizing an MI355X kernel written in HIP

```python
import math
import jax, jax.numpy as jnp
from jax import lax
import numpy as np

D_MODEL = 1024
BATCH = 4
SEQ = 8192
DEPTH = 1

CTX_LEN = 256
GRID_W = 64
EPS = 1e-6
MIX_WIDTH = D_MODEL
GLA_WIDTH = MIX_WIDTH // 2
DIFF_WIDTH = MIX_WIDTH - GLA_WIDTH
GLA_HEADS = 4
GLA_DV = GLA_WIDTH // GLA_HEADS
GLA_DK = GLA_DV // 2
GLA_QK = GLA_HEADS * GLA_DK
GLA_GATE_RANK = 16
GLA_GATE_NORM = 16.0
GLA_CHUNK = 64
DIFF_HEADS = 4
DIFF_DV = DIFF_WIDTH // DIFF_HEADS
DIFF_DH = DIFF_DV // 2
ROPE_BASE = 10000.0
ROPE_AXIS_DIM = DIFF_DH // 2
Q_BLOCK = 128
FFN_HIDDEN = ((8 * D_MODEL // 3 + 255) // 256) * 256
IN_SIZES = (GLA_QK, GLA_QK, GLA_WIDTH, GLA_WIDTH, 2 * GLA_GATE_RANK, DIFF_WIDTH, DIFF_WIDTH, DIFF_WIDTH)
W_IN_COLS = sum(IN_SIZES)

kernel_name = "hymba_gla_diffattn_dit_block"


def rmsnorm(x, g):
    xf = x.astype(jnp.float32)
    y = xf * lax.rsqrt(jnp.mean(xf * xf, axis=-1, keepdims=True) + EPS)
    return (y * g.astype(jnp.float32)).astype(x.dtype)


def modulate(x, g, shift, scale):
    return rmsnorm(x, g) * (1 + scale) + shift


def split_heads(t, n_heads):
    b, n, _ = t.shape
    return t.reshape(b, n, n_heads, -1).transpose(0, 2, 1, 3)


def merge_heads(t):
    b, h, n, d = t.shape
    return t.transpose(0, 2, 1, 3).reshape(b, n, h * d)


def adaln_params(cond, w_mod, b_mod):
    return jnp.split(jax.nn.silu(cond) @ w_mod + b_mod, 6, axis=-1)


def axial_rope_tables(n_tokens):
    rows = n_tokens // GRID_W
    t = jnp.arange(rows * GRID_W)
    row = (t // GRID_W).astype(jnp.float32)
    col = (t % GRID_W).astype(jnp.float32)
    n_freq = ROPE_AXIS_DIM // 2
    inv_freq = ROPE_BASE ** (-jnp.arange(n_freq, dtype=jnp.float32) / n_freq)
    ang = jnp.stack([row[:, None] * inv_freq, col[:, None] * inv_freq], axis=1)
    return jnp.cos(ang), jnp.sin(ang)


def apply_axial_rope(x, cos, sin):
    xr = x.reshape(x.shape[:-1] + (2, 2, ROPE_AXIS_DIM // 2))
    x1, x2 = xr[..., 0, :], xr[..., 1, :]
    cs = cos[:, None].astype(x.dtype)
    sn = sin[:, None].astype(x.dtype)
    out = jnp.stack([x1 * cs - x2 * sn, x2 * cs + x1 * sn], axis=-2)
    return out.reshape(x.shape)


def project(h, w_in):
    points = np.cumsum(IN_SIZES)[:-1].tolist()
    return jnp.split(h @ w_in, points, axis=-1)


def gla_inputs(parts, gate_up, gate_bias):
    gq, gk, gv, gr, gdown = parts[:5]
    q = split_heads(gq, GLA_HEADS) * (GLA_DK ** -0.5)
    k = split_heads(gk, GLA_HEADS)
    v = split_heads(gv, GLA_HEADS)
    down = gdown.astype(jnp.float32).reshape(gdown.shape[:-1] + (2, GLA_GATE_RANK))
    logits = jnp.einsum('bnzr,zrk->bnzk', down, gate_up.astype(jnp.float32)) + gate_bias.astype(jnp.float32)
    log_alpha = jax.nn.log_sigmoid(logits) / GLA_GATE_NORM
    g_f = split_heads(log_alpha[:, :, 0], GLA_HEADS)
    g_b = split_heads(log_alpha[:, :, 1], GLA_HEADS)
    return q, k, v, gr, g_f, g_b


def gla_chunk_scan(q, k, v, g, s0):
    b, h, n, dk = q.shape
    dv = v.shape[-1]
    nc = n // GLA_CHUNK

    def chunks(t):
        return jnp.moveaxis(t.astype(jnp.float32).reshape(b, h, nc, GLA_CHUNK, t.shape[-1]), 2, 0)

    mask = jnp.tril(jnp.ones((GLA_CHUNK, GLA_CHUNK), dtype=bool))

    def step(state, inp):
        qc, kc, vc, gc = inp
        cum = jnp.cumsum(gc, axis=2)
        o_inter = jnp.einsum('bhcd,bhde->bhce', qc * jnp.exp(cum), state)
        rel = cum[:, :, :, None, :] - cum[:, :, None, :, :]
        decay = jnp.exp(jnp.where(mask[:, :, None], rel, -jnp.inf))
        attn = jnp.einsum('bhid,bhjd,bhijd->bhij', qc, kc, decay)
        o = o_inter + jnp.einsum('bhij,bhje->bhie', attn, vc)
        last = cum[:, :, -1:, :]
        state = jnp.exp(last[:, :, 0, :, None]) * state + jnp.einsum('bhcd,bhce->bhde', kc * jnp.exp(last - cum), vc)
        return state, o

    s_final, o = lax.scan(step, s0, (chunks(q), chunks(k), chunks(v), chunks(g)))
    o = jnp.moveaxis(o, 0, 2).reshape(b, h, n, dv)
    return s_final, o.astype(v.dtype)


def gla_bidir(q, k, v, g_f, g_b, s0_f, s0_b):
    flip = lambda t: jnp.flip(t, axis=2)
    s_f, o_f = gla_chunk_scan(q, k, v, g_f, s0_f)
    s_b, o_b = gla_chunk_scan(flip(q), flip(k), flip(v), flip(g_b), s0_b)
    return s_f, s_b, o_f + flip(o_b)


def gla_merge(o, r, norm_g):
    return merge_heads(rmsnorm(o, norm_g)) * jax.nn.silu(r)


def diff_qkv(parts, q_norm_g, k_norm_g):
    dq, dk, dv = parts[5:]
    b, n, _ = dq.shape
    q = rmsnorm(dq.reshape(b, n, DIFF_HEADS, 2, DIFF_DH).transpose(0, 2, 1, 3, 4), q_norm_g)
    k = rmsnorm(dk.reshape(b, n, DIFF_HEADS, 2, DIFF_DH).transpose(0, 2, 1, 3, 4), k_norm_g)
    v = split_heads(dv, DIFF_HEADS)
    return q, k, v


def diff_attend(q, k_all, v_all, lam):
    b, h, n = q.shape[:3]
    nb = n // Q_BLOCK
    q_blocks = jnp.moveaxis(q.reshape(b, h, nb, Q_BLOCK, 2, DIFF_DH), 2, 0)

    def one_block(qb):
        s = jnp.einsum('bhqcd,bhkcd->bhcqk', qb, k_all).astype(jnp.float32) * (DIFF_DH ** -0.5)
        p = jax.nn.softmax(s, axis=-1)
        a = (p[:, :, 0] - lam.astype(jnp.float32) * p[:, :, 1]).astype(v_all.dtype)
        return jnp.einsum('bhqk,bhkd->bhqd', a, v_all)

    o = lax.map(one_block, q_blocks)
    return jnp.moveaxis(o, 0, 2).reshape(b, h, n, DIFF_DV)


def diff_merge(o, norm_g, lam_init):
    return merge_heads(rmsnorm(o, norm_g) * (1.0 - lam_init))


def swiglu(h, w_in, w_out):
    gate, up = jnp.split(h @ w_in, 2, axis=-1)
    return (jax.nn.silu(gate) * up) @ w_out


def setup_inputs(seed: int = 0) -> dict:
    key = jax.random.key(seed)
    ks = jax.random.split(key, 20)
    f32 = jnp.float32
    nrm = lambda k, shape, s: jax.random.normal(k, shape, f32) * s
    return {
        "x": nrm(ks[0], (BATCH, SEQ, D_MODEL), 1.0),
        "c": nrm(ks[1], (BATCH, D_MODEL), 1.0),
        "ctx": nrm(ks[2], (BATCH, CTX_LEN, D_MODEL), 1.0),
        "c_ctx": nrm(ks[3], (D_MODEL,), 1.0),
        "w_mod": nrm(ks[4], (DEPTH, D_MODEL, 6 * D_MODEL), 0.5 * D_MODEL ** -0.5),
        "b_mod": nrm(ks[5], (DEPTH, 6 * D_MODEL), 0.01),
        "norm1_g": 1.0 + nrm(ks[6], (DEPTH, D_MODEL), 0.02),
        "w_in": nrm(ks[7], (DEPTH, D_MODEL, W_IN_COLS), D_MODEL ** -0.5),
        "gla_gate_up": nrm(ks[8], (DEPTH, 2, GLA_GATE_RANK, GLA_QK), GLA_GATE_RANK ** -0.5),
        "gla_gate_bias": nrm(ks[9], (DEPTH, 2, GLA_QK), 0.1),
        "gla_norm_g": 1.0 + nrm(ks[10], (DEPTH, GLA_DV), 0.02),
        "diff_q_norm_g": 1.0 + nrm(ks[11], (DEPTH, DIFF_DH), 0.02),
        "diff_k_norm_g": 1.0 + nrm(ks[12], (DEPTH, DIFF_DH), 0.02),
        "diff_lambda_q": nrm(ks[13], (DEPTH, 2, DIFF_DH), 0.1),
        "diff_lambda_k": nrm(ks[14], (DEPTH, 2, DIFF_DH), 0.1),
        "diff_norm_g": 1.0 + nrm(ks[15], (DEPTH, DIFF_DV), 0.02),
        "w_out": nrm(ks[16], (DEPTH, MIX_WIDTH, D_MODEL), MIX_WIDTH ** -0.5),
        "norm2_g": 1.0 + nrm(ks[17], (DEPTH, D_MODEL), 0.02),
        "w_ffn_in": nrm(ks[18], (DEPTH, D_MODEL, 2 * FFN_HIDDEN), D_MODEL ** -0.5),
        "w_ffn_out": nrm(ks[19], (DEPTH, FFN_HIDDEN, D_MODEL), FFN_HIDDEN ** -0.5),
    }


def reference(x, c, ctx, c_ctx, w_mod, b_mod, norm1_g, w_in, gla_gate_up, gla_gate_bias, gla_norm_g,
              diff_q_norm_g, diff_k_norm_g, diff_lambda_q, diff_lambda_k, diff_norm_g, w_out, norm2_g,
              w_ffn_in, w_ffn_out):
    b = x.shape[0]
    cos, sin = axial_rope_tables(x.shape[1])
    zero_state = jnp.zeros((b, GLA_HEADS, GLA_DK, GLA_DV), jnp.float32)
    for l in range(DEPTH):
        lam_init = 0.8 - 0.6 * math.exp(-0.3 * l)
        lam = (jnp.exp(jnp.sum(diff_lambda_q[l, 0] * diff_lambda_k[l, 0]))
               - jnp.exp(jnp.sum(diff_lambda_q[l, 1] * diff_lambda_k[l, 1])) + lam_init)
        sh1, sc1, gt1, sh2, sc2, gt2 = [m[:, None, :] for m in adaln_params(c, w_mod[l], b_mod[l])]
        csh1, csc1, cgt1, csh2, csc2, cgt2 = adaln_params(c_ctx, w_mod[l], b_mod[l])

        pc = project(modulate(ctx, norm1_g[l], csh1, csc1), w_in[l])
        qg_c, kg_c, vg_c, r_c, gf_c, gb_c = gla_inputs(pc, gla_gate_up[l], gla_gate_bias[l])
        s_f, s_b, og_c = gla_bidir(qg_c, kg_c, vg_c, gf_c, gb_c, zero_state, zero_state)
        qd_c, kd_c, vd_c = diff_qkv(pc, diff_q_norm_g[l], diff_k_norm_g[l])

        px = project(modulate(x, norm1_g[l], sh1, sc1), w_in[l])
        qg, kg, vg, r, gf, gb = gla_inputs(px, gla_gate_up[l], gla_gate_bias[l])
        _, _, og = gla_bidir(qg, kg, vg, gf, gb, s_f, s_b)
        qd, kd, vd = diff_qkv(px, diff_q_norm_g[l], diff_k_norm_g[l])
        qd = apply_axial_rope(qd, cos, sin)
        kd = apply_axial_rope(kd, cos, sin)
        od = diff_attend(qd, jnp.concatenate([kd_c, kd], axis=2), jnp.concatenate([vd_c, vd], axis=2), lam)
        mix = jnp.concatenate([gla_merge(og, r, gla_norm_g[l]), diff_merge(od, diff_norm_g[l], lam_init)], axis=-1) @ w_out[l]
        x = x + gt1 * mix
        x = x + gt2 * swiglu(modulate(x, norm2_g[l], sh2, sc2), w_ffn_in[l], w_ffn_out[l])

        if l < DEPTH - 1:
            od_c = diff_attend(qd_c, kd_c, vd_c, lam)
            mix_c = jnp.concatenate([gla_merge(og_c, r_c, gla_norm_g[l]), diff_merge(od_c, diff_norm_g[l], lam_init)], axis=-1) @ w_out[l]
            ctx = ctx + cgt1 * mix_c
            ctx = ctx + cgt2 * swiglu(modulate(ctx, norm2_g[l], csh2, csc2), w_ffn_in[l], w_ffn_out[l])
    return x
```

```cpp
#include <hip/hip_runtime.h>
#include <hip/hip_cooperative_groups.h>
#include <cstdio>
#include <cstdint>
namespace cg = cooperative_groups;

#define DI __device__ __forceinline__
#define LAS __attribute__((address_space(3)))
typedef unsigned short bf16_t;
typedef short bf16x8 __attribute__((ext_vector_type(8)));
typedef short s16x4 __attribute__((ext_vector_type(4)));
typedef float f32x4 __attribute__((ext_vector_type(4)));
typedef float f32x16 __attribute__((ext_vector_type(16)));
typedef unsigned u32x4 __attribute__((ext_vector_type(4)));
typedef unsigned u32x2 __attribute__((ext_vector_type(2)));
typedef __bf16 bf2_t __attribute__((ext_vector_type(2)));
typedef float f32x2 __attribute__((ext_vector_type(2)));

constexpr int D = 1024, NB = 4, SEQ = 8192, CTXL = 256;
constexpr int NLAT = NB * SEQ, NCTX = NB * CTXL, NT = NLAT + NCTX;
constexpr int PW = 3328;
constexpr int C_GQ = 0, C_GK = 256, C_GV = 512, C_GR = 1024, C_DQ = 1536, C_DK = 2048, C_DV = 2560, C_GD = 3072;
constexpr int FH = 2816, FH2 = 5632;
constexpr int NPOS = 132;
constexpr float EPS = 1e-6f;
constexpr int NTHR = 512;
constexpr int LDS_MAIN = 131072;
constexpr int LDS_BYTES = LDS_MAIN + 256;

constexpr size_t al256(size_t x) { return (x + 255) & ~(size_t)255; }
constexpr size_t WS_CTL = 0;
constexpr size_t WS_BAR = 4096;
constexpr size_t WS_MOD = 4096 + 16384;
constexpr size_t WS_ROPE = al256(WS_MOD + 5 * 6144 * 4);
constexpr size_t WS_ROWSS = al256(WS_ROPE + 128 * 16 * 8);
constexpr size_t WS_BIAS2 = al256(WS_ROWSS + (size_t)NLAT * 4);
constexpr size_t WS_DEC = al256(WS_BIAS2 + (size_t)NB * FH2 * 4);
constexpr size_t WS_GD = al256(WS_DEC + (size_t)32 * NPOS * 64 * 4);
constexpr size_t WS_WIN = al256(WS_GD + (size_t)NT * 32 * 4);
constexpr size_t WS_WOUT = al256(WS_WIN + (size_t)PW * D * 2);
constexpr size_t WS_WF1 = al256(WS_WOUT + (size_t)D * D * 2);
constexpr size_t WS_WF2 = al256(WS_WF1 + (size_t)FH2 * D * 2);
constexpr size_t WS_H = al256(WS_WF2 + (size_t)D * FH * 2);
constexpr size_t WS_MIX = al256(WS_H + (size_t)NT * D * 2);
constexpr size_t WS_DS = al256(WS_MIX + (size_t)NLAT * D * 2);
constexpr size_t WS_P = al256(WS_DS + (size_t)32 * NPOS * 8192 * 2);
constexpr size_t WS_END = al256(WS_P + (size_t)NT * PW * 2);

struct Params {
    const float *x, *c, *ctx, *c_ctx, *w_mod, *b_mod, *norm1_g, *w_in, *gate_up, *gate_bias, *gla_norm_g, *q_norm_g, *k_norm_g, *lam_q, *lam_k, *diff_norm_g,
        *w_out, *norm2_g, *w_ffn_in, *w_ffn_out;
    float* out; unsigned char* ws; int ph_lo, ph_hi;
};

DI unsigned pk_bf16(float lo, float hi) { f32x2 v = {lo, hi}; bf2_t r = __builtin_convertvector(v, bf2_t); return __builtin_bit_cast(unsigned, r); }
DI float bf_lo(unsigned u) { return __uint_as_float(u << 16); }
DI float bf_hi(unsigned u) { return __uint_as_float(u & 0xffff0000u); }
DI float silu_f(float v) { return v * __builtin_amdgcn_rcpf(1.f + __expf(-v)); }
DI float logsig2_16(float z) {
    const float l = __builtin_amdgcn_logf(1.0f + __builtin_amdgcn_exp2f(-fabsf(z)));
    return (fminf(z, 0.f) - l) * (1.0f / 16.0f);
}
DI float logsig_f(float z) { return fminf(z, 0.f) - __logf(1.0f + __expf(-fabsf(z))); }
DI int my_tid() { int t = threadIdx.x; asm volatile("" : "+v"(t)); return t; }
DI float wave_allreduce_sum(float x) {
    x += __builtin_bit_cast(float, __builtin_amdgcn_update_dpp(0, __builtin_bit_cast(int, x), 0xB1, 0xf, 0xf, false));
    x += __builtin_bit_cast(float, __builtin_amdgcn_update_dpp(0, __builtin_bit_cast(int, x), 0x4E, 0xf, 0xf, false));
    x += __builtin_bit_cast(float, __builtin_amdgcn_update_dpp(0, __builtin_bit_cast(int, x), 0x141, 0xf, 0xf, false));
    x += __builtin_bit_cast(float, __builtin_amdgcn_update_dpp(0, __builtin_bit_cast(int, x), 0x140, 0xf, 0xf, false));
    const int xi = __builtin_bit_cast(int, x);
    return (__builtin_bit_cast(float, __builtin_amdgcn_readlane(xi, 0)) + __builtin_bit_cast(float, __builtin_amdgcn_readlane(xi, 16)))
         + (__builtin_bit_cast(float, __builtin_amdgcn_readlane(xi, 32)) + __builtin_bit_cast(float, __builtin_amdgcn_readlane(xi, 48)));
}
DI int crow(int reg, int h) { return (reg & 3) + 8 * (reg >> 2) + 4 * h; }
#define MFMA32(a, b, c) __builtin_amdgcn_mfma_f32_32x32x16_bf16((a), (b), (c), 0, 0, 0)
DI bf16x8 tr_frag(const LAS unsigned char* base, int hi_off) {
    s16x4 lo = __builtin_amdgcn_ds_read_tr16_b64_v4i16((LAS s16x4*)base);
    s16x4 hi = __builtin_amdgcn_ds_read_tr16_b64_v4i16((LAS s16x4*)(base + hi_off));
    return __builtin_shufflevector(lo, hi, 0, 1, 2, 3, 4, 5, 6, 7);
}
DI int srccol(int which, int n) {
    if (which == 0) { if (n < 1536) return n; if (n < 3072) return n + 32; if (n < 3104) return n - 1536; return -1; }
    if (which == 2) { const int pn = n >> 8, bj = (n >> 7) & 1, cc = n & 127; return bj * FH + pn * 128 + cc; }
    return n;
}

namespace pg8 {
constexpr int BM = 256, BK = 64, HALF = 128, HTB = HALF * BK * 2, STAGE_BYTES = 8 * HTB, NXCD = 8, WGM = 8;
DI int lds_byte(int r, int c) { const int st = (r >> 4) * 2 + (c >> 5), rr = r & 15, cc = c & 31, ob = rr * 64 + cc * 2; return st * 1024 + (ob ^ (((ob >> 9) & 1) << 5)); }
DI void stage_rc(int b, int& R, int& C) { const int st = b / 1024, sb = b % 1024, swz = sb ^ (((sb >> 9) & 1) << 5); R = (st >> 1) * 16 + swz / 64; C = (st & 1) * 32 + (swz % 64) / 2; }
DI int perm32(int rho) { const int n = rho >> 4, i = rho & 15; return 8 * (i >> 2) + 4 * n + (i & 3); }
struct Unit { int pm, pn; };
struct Gemm { const bf16_t* A; const bf16_t* Bt; int M, N, K; };
struct StaticOrder {
    int nM, nN, nwg, G, c;
    DI void init(int M, int N, int G_, int c_) { nM = M / BM; nN = N / BM; nwg = nM * nN; G = G_; c = c_; }
    DI bool next(int i, Unit& u) const {
        const long L = (long)i * G + c; if (L >= nwg) return false;
        int wgid = (int)L; { const int q = nwg / NXCD, r = nwg % NXCD, xcd = wgid % NXCD, off = wgid / NXCD; wgid = (xcd < r ? xcd * (q + 1) : r * (q + 1) + (xcd - r) * q) + off; }
        const int nig = WGM * nN, gid = wgid / nig, fm = gid * WGM, gsz = (nM - fm) < WGM ? (nM - fm) : WGM;
        u.pm = fm + ((wgid % nig) % gsz); u.pn = (wgid % nig) / gsz; return true;
    }
    DI void a_ready(const Unit&) const {}
    DI void done(const Unit&) const {}
};
template <class Epi, class Sched, bool ALIGN_EPI = false, bool SP2 = false>
DI void gemm_phase(LAS unsigned char* lds, const Gemm g, const Sched& S, const Epi& E) {
    const int tid = my_tid(), wid = __builtin_amdgcn_readfirstlane(tid >> 6), lane = tid & 63, wr = wid >> 2, wc = wid & 3, fr = lane & 15, fq = lane >> 4;
    const int K = g.K, nt = K / BK;
    unsigned voffA[2], voffB[2];
#pragma unroll
    for (int i = 0; i < 2; ++i) { int R, C; stage_rc(tid * 16 + i * 8192, R, C); const int Rb = Epi::PERM ? ((R & ~31) + perm32(R & 31)) : R;
        voffA[i] = (unsigned)(R * K + C) * 2u; voffB[i] = (unsigned)(Rb * K + C) * 2u; }
    const size_t kstep = (size_t)(BK * 2);
    const size_t hstep = (size_t)HALF * K * 2;
    const size_t tstep = 2 * hstep;
    const unsigned ldsw = (unsigned)wid * 1024u;
    const int aoff = lds_byte(wr * 64 + fr, fq * 8), boff = lds_byte(wc * 32 + fr, fq * 8);
#define PG8_SA(b, h) (((b) * 2 + (h)) * HTB)
#define PG8_SB(b, h) ((4 + (b) * 2 + (h)) * HTB)
#define PG8_STAGE(bufoff, gbase, voff) do { _Pragma("unroll") for (int _i = 0; _i < 2; ++_i) \
        __builtin_amdgcn_global_load_lds((const unsigned*)((const char*)(gbase) + (voff)[_i]), (LAS unsigned*)(lds + (bufoff) + ldsw + _i * 8192), 16, 0, 0); } while (0)
#define PG8_LDA(dst, b, h) do { _Pragma("unroll") for (int m = 0; m < 4; ++m) _Pragma("unroll") for (int k = 0; k < 2; ++k) dst[m][k] = *(const LAS bf16x8*)(lds + PG8_SA(b, h) + aoff + m * 2048 + k * 1024); } while (0)
#define PG8_LDB(dst, b, h) do { _Pragma("unroll") for (int n = 0; n < 2; ++n) _Pragma("unroll") for (int k = 0; k < 2; ++k) dst[n][k] = *(const LAS bf16x8*)(lds + PG8_SB(b, h) + boff + n * 2048 + k * 1024); } while (0)
#define PG8_MMA(ai, bj, At, Bt) do { __builtin_amdgcn_s_setprio(1); _Pragma("unroll") for (int m = 0; m < 4; ++m) _Pragma("unroll") for (int n = 0; n < 2; ++n) _Pragma("unroll") for (int k = 0; k < 2; ++k) \
        acc[ai][bj][m][n] = __builtin_amdgcn_mfma_f32_16x16x32_bf16(Bt[n][k], At[m][k], acc[ai][bj][m][n], 0, 0, 0); __builtin_amdgcn_s_setprio(0); } while (0)
#define PG8_WAIT_V(n) asm volatile("s_waitcnt vmcnt(" #n ")" ::: "memory")
#define PG8_WAIT_L(n) asm volatile("s_waitcnt lgkmcnt(" #n ")" ::: "memory")
#define PG8_BAR __builtin_amdgcn_s_barrier()
#define PG8_SCHED __builtin_amdgcn_sched_barrier(0)
    Unit cur, nxt; int ui = 0;
    if (!S.next(0, cur)) return;
    f32x4 acc[2][2][4][2];
#pragma unroll
    for (int a = 0; a < 2; ++a)
#pragma unroll
        for (int b = 0; b < 2; ++b)
#pragma unroll
            for (int m = 0; m < 4; ++m)
#pragma unroll
                for (int n = 0; n < 2; ++n) acc[a][b][m][n] = (f32x4){0.f, 0.f, 0.f, 0.f};
    bf16x8 At[4][2], B0[2][2], B1[2][2];
    const char* cA = (const char*)g.A + (size_t)cur.pm * tstep; const char* cB = (const char*)g.Bt + (size_t)cur.pn * tstep;
    S.a_ready(cur);
    if constexpr (SP2) {
        PG8_STAGE(PG8_SB(0, 0), cB, voffB); PG8_STAGE(PG8_SB(0, 1), cB + hstep, voffB); PG8_STAGE(PG8_SA(0, 0), cA, voffA); PG8_STAGE(PG8_SA(0, 1), cA + hstep, voffA);
        if (wr == 1) PG8_BAR;
        PG8_WAIT_V(2); PG8_BAR;
        PG8_STAGE(PG8_SB(1, 0), cB + kstep, voffB); PG8_STAGE(PG8_SA(1, 0), cA + kstep, voffA); PG8_STAGE(PG8_SB(1, 1), cB + hstep + kstep, voffB);
        PG8_WAIT_V(6); PG8_BAR;
    } else {
        PG8_STAGE(PG8_SB(0, 0), cB, voffB); PG8_STAGE(PG8_SA(0, 0), cA, voffA); PG8_STAGE(PG8_SB(0, 1), cB + hstep, voffB); PG8_STAGE(PG8_SA(0, 1), cA + hstep, voffA);
        if (wr == 1) PG8_BAR;
        PG8_WAIT_V(4); PG8_BAR;
        PG8_STAGE(PG8_SB(1, 0), cB + kstep, voffB); PG8_STAGE(PG8_SA(1, 0), cA + kstep, voffA); PG8_STAGE(PG8_SB(1, 1), cB + hstep + kstep, voffB);
        PG8_WAIT_V(6); PG8_BAR;
    }
    for (;;) {
        const bool has_next = S.next(ui + 1, nxt);
        const char* nA = has_next ? (const char*)g.A + (size_t)nxt.pm * tstep : cA; const char* nB = has_next ? (const char*)g.Bt + (size_t)nxt.pn * tstep : cB;
        for (int t = 0; t < nt; t += 2) {
            const bool last = (t == nt - 2);
            const char* a1 = cA + (size_t)(t + 1) * kstep;
            const char* a2 = last ? nA : cA + (size_t)(t + 2) * kstep; const char* b2 = last ? nB : cB + (size_t)(t + 2) * kstep;
            const char* a3 = a2 + kstep; const char* b3 = b2 + kstep;
            if (last && has_next) S.a_ready(nxt);
            if constexpr (SP2) {
            PG8_LDB(B0, 0, 0); PG8_LDB(B1, 0, 1); PG8_SCHED; PG8_LDA(At, 0, 0); PG8_STAGE(PG8_SA(1, 1), a1 + hstep, voffA);
            PG8_WAIT_V(8); PG8_WAIT_L(0); PG8_BAR; PG8_MMA(0, 0, At, B0); PG8_MMA(0, 1, At, B1); PG8_BAR; PG8_SCHED;
            PG8_LDA(At, 0, 1); PG8_STAGE(PG8_SB(0, 0), b2, voffB); PG8_STAGE(PG8_SB(0, 1), b2 + hstep, voffB); PG8_STAGE(PG8_SA(0, 0), a2, voffA);
            PG8_WAIT_V(8); PG8_WAIT_L(0); PG8_BAR; PG8_MMA(1, 0, At, B0); PG8_MMA(1, 1, At, B1); PG8_BAR; PG8_SCHED;
            PG8_LDB(B0, 1, 0); PG8_LDB(B1, 1, 1); PG8_SCHED; PG8_LDA(At, 1, 0); PG8_STAGE(PG8_SA(0, 1), a2 + hstep, voffA);
            PG8_WAIT_V(8); PG8_WAIT_L(0); PG8_BAR; PG8_MMA(0, 0, At, B0); PG8_MMA(0, 1, At, B1); PG8_BAR; PG8_SCHED;
            PG8_LDA(At, 1, 1); PG8_STAGE(PG8_SB(1, 0), b3, voffB); PG8_STAGE(PG8_SB(1, 1), b3 + hstep, voffB); PG8_STAGE(PG8_SA(1, 0), a3, voffA);
            PG8_WAIT_V(8); PG8_WAIT_L(0); PG8_BAR; PG8_MMA(1, 0, At, B0); PG8_MMA(1, 1, At, B1); PG8_BAR; PG8_SCHED;
            } else {
            PG8_LDB(B0, 0, 0); PG8_SCHED; PG8_LDA(At, 0, 0); PG8_STAGE(PG8_SA(1, 1), a1 + hstep, voffA);
            PG8_WAIT_L(8); PG8_BAR; PG8_WAIT_L(0); PG8_MMA(0, 0, At, B0); PG8_BAR; PG8_SCHED;
            PG8_LDB(B1, 0, 1); PG8_STAGE(PG8_SB(0, 0), b2, voffB);
            PG8_BAR; PG8_WAIT_L(0); PG8_MMA(0, 1, At, B1); PG8_BAR;
            PG8_LDA(At, 0, 1); PG8_STAGE(PG8_SA(0, 0), a2, voffA);
            PG8_BAR; PG8_WAIT_L(0); PG8_MMA(1, 0, At, B0); PG8_BAR; PG8_SCHED;
            PG8_STAGE(PG8_SB(0, 1), b2 + hstep, voffB);
            PG8_WAIT_V(6); PG8_BAR; PG8_MMA(1, 1, At, B1); PG8_BAR;
            PG8_LDB(B0, 1, 0); PG8_SCHED; PG8_LDA(At, 1, 0); PG8_STAGE(PG8_SA(0, 1), a2 + hstep, voffA);
            PG8_WAIT_L(8); PG8_BAR; PG8_WAIT_L(0); PG8_MMA(0, 0, At, B0); PG8_BAR; PG8_SCHED;
            PG8_LDB(B1, 1, 1); PG8_STAGE(PG8_SB(1, 0), b3, voffB);
            PG8_BAR; PG8_WAIT_L(0); PG8_MMA(0, 1, At, B1); PG8_BAR;
            PG8_LDA(At, 1, 1); PG8_STAGE(PG8_SA(1, 0), a3, voffA);
            PG8_BAR; PG8_WAIT_L(0); PG8_MMA(1, 0, At, B0); PG8_BAR; PG8_SCHED;
            PG8_STAGE(PG8_SB(1, 1), b3 + hstep, voffB);
            PG8_WAIT_V(6); PG8_BAR; PG8_MMA(1, 1, At, B1); PG8_BAR;
            }
        }
        if constexpr (ALIGN_EPI) { if (wr == 0) PG8_BAR; }
        E(acc, cur, wr, wc, fr, fq);
        if (!has_next) break;
#pragma unroll
        for (int a = 0; a < 2; ++a)
#pragma unroll
            for (int b = 0; b < 2; ++b)
#pragma unroll
                for (int m = 0; m < 4; ++m)
#pragma unroll
                    for (int n = 0; n < 2; ++n) acc[a][b][m][n] = (f32x4){0.f, 0.f, 0.f, 0.f};
        cur = nxt; cA = nA; cB = nB; ++ui;
        if constexpr (ALIGN_EPI) { if (wr == 1) PG8_BAR; }
    }
    PG8_WAIT_V(0);
    if constexpr (!ALIGN_EPI) { if (wr == 0) PG8_BAR; }
    PG8_BAR;
#undef PG8_SA
#undef PG8_SB
#undef PG8_STAGE
#undef PG8_LDA
#undef PG8_LDB
#undef PG8_MMA
#undef PG8_WAIT_V
#undef PG8_WAIT_L
#undef PG8_BAR
#undef PG8_SCHED
}
}

typedef f32x4 AccT[2][2][4][2];

struct EpiInProj {
    static constexpr bool PERM = true;
    bf16_t* P; float* GD;
    DI void operator()(const AccT& acc, const pg8::Unit& u, int wr, int wc, int fr, int fq) const {
        const int row0 = u.pm * 256 + wr * 64 + fr;
        if (u.pn < 12) {
            const int col0 = u.pn * 256 + wc * 32 + 8 * fq;
#pragma unroll
            for (int ai = 0; ai < 2; ++ai)
#pragma unroll
                for (int m = 0; m < 4; ++m) { bf16_t* rowp = P + (size_t)(row0 + ai * 128 + m * 16) * PW + col0;
#pragma unroll
                    for (int bj = 0; bj < 2; ++bj) { const f32x4 v0 = acc[ai][bj][m][0], v1 = acc[ai][bj][m][1];
                        u32x4 w; w.x = pk_bf16(v0[0], v0[1]); w.y = pk_bf16(v0[2], v0[3]); w.z = pk_bf16(v1[0], v1[1]); w.w = pk_bf16(v1[2], v1[3]);
                        *(u32x4*)(rowp + bj * 128) = w; } }
        } else if (wc == 0) {
#pragma unroll
            for (int ai = 0; ai < 2; ++ai)
#pragma unroll
                for (int m = 0; m < 4; ++m) { float* rowp = GD + (size_t)(row0 + ai * 128 + m * 16) * 32 + 8 * fq;
                    *(f32x4*)(rowp) = acc[ai][0][m][0]; *(f32x4*)(rowp + 4) = acc[ai][0][m][1]; }
        }
    }
};
struct EpiOutProj {
    static constexpr bool PERM = true;
    const float* x; const float* mod; const float* n2g; float* out; bf16_t* H2; float* rowss;
    DI void operator()(const AccT& acc, const pg8::Unit& u, int wr, int wc, int fr, int fq) const {
        const int row0 = u.pm * 256 + wr * 64 + fr; const int b = (u.pm * 256) >> 13;
        const float* mb = mod + b * 6144;
#pragma unroll
        for (int ai = 0; ai < 2; ++ai)
#pragma unroll
            for (int m = 0; m < 4; ++m) { const int row = row0 + ai * 128 + m * 16; float ss = 0.f;
#pragma unroll
                for (int bj = 0; bj < 2; ++bj) { const int c0 = u.pn * 256 + bj * 128 + wc * 32 + 8 * fq; const size_t off = (size_t)row * D + c0;
                    unsigned w[4];
#pragma unroll
                    for (int n = 0; n < 2; ++n) { const f32x4 xv = *(const f32x4*)(x + off + 4 * n); const f32x4 gt = *(const f32x4*)(mb + 2048 + c0 + 4 * n);
                        const f32x4 sc = *(const f32x4*)(mb + 4096 + c0 + 4 * n); const f32x4 gg = *(const f32x4*)(n2g + c0 + 4 * n);
                        const f32x4 x1 = xv + gt * acc[ai][bj][m][n]; *(f32x4*)(out + off + 4 * n) = x1;
                        ss += (x1[0] * x1[0] + x1[1] * x1[1]) + (x1[2] * x1[2] + x1[3] * x1[3]);
                        const f32x4 hv = x1 * gg * (sc + 1.0f); w[2 * n] = pk_bf16(hv[0], hv[1]); w[2 * n + 1] = pk_bf16(hv[2], hv[3]); }
                    u32x4 ww; ww.x = w[0]; ww.y = w[1]; ww.z = w[2]; ww.w = w[3]; *(u32x4*)(H2 + off) = ww; }
                ss += __shfl_xor(ss, 16); ss += __shfl_xor(ss, 32);
                if (fq == 0) atomicAdd(rowss + row, ss); }
    }
};
struct EpiFfnIn {
    static constexpr bool PERM = true;
    const float* rowss; const float* bias2; bf16_t* ACT;
    DI void operator()(const AccT& acc, const pg8::Unit& u, int wr, int wc, int fr, int fq) const {
        const int row0 = u.pm * 256 + wr * 64 + fr; const int b = (u.pm * 256) >> 13;
        const float* bb = bias2 + b * FH2 + u.pn * 256 + wc * 32 + 8 * fq;
        f32x4 bg[2], bu[2];
#pragma unroll
        for (int n = 0; n < 2; ++n) { bg[n] = *(const f32x4*)(bb + 4 * n); bu[n] = *(const f32x4*)(bb + 128 + 4 * n); }
#pragma unroll
        for (int ai = 0; ai < 2; ++ai)
#pragma unroll
            for (int m = 0; m < 4; ++m) { const int row = row0 + ai * 128 + m * 16; const float rs = rsqrtf(rowss[row] * (1.0f / 1024.0f) + EPS);
                unsigned w[4];
#pragma unroll
                for (int n = 0; n < 2; ++n) { const f32x4 gt = acc[ai][0][m][n] * rs + bg[n]; const f32x4 up = acc[ai][1][m][n] * rs + bu[n];
                    w[2 * n] = pk_bf16(silu_f(gt[0]) * up[0], silu_f(gt[1]) * up[1]); w[2 * n + 1] = pk_bf16(silu_f(gt[2]) * up[2], silu_f(gt[3]) * up[3]); }
                u32x4 ww; ww.x = w[0]; ww.y = w[1]; ww.z = w[2]; ww.w = w[3];
                *(u32x4*)(ACT + (size_t)row * FH + u.pn * 128 + wc * 32 + 8 * fq) = ww; }
    }
};
struct EpiFfnOut {
    static constexpr bool PERM = true;
    const float* mod; float* out;
    DI void operator()(const AccT& acc, const pg8::Unit& u, int wr, int wc, int fr, int fq) const {
        const int row0 = u.pm * 256 + wr * 64 + fr; const int b = (u.pm * 256) >> 13;
        const float* mb = mod + b * 6144 + 5120;
#pragma unroll
        for (int ai = 0; ai < 2; ++ai)
#pragma unroll
            for (int m = 0; m < 4; ++m) { const int row = row0 + ai * 128 + m * 16;
#pragma unroll
                for (int bj = 0; bj < 2; ++bj) { const int c0 = u.pn * 256 + bj * 128 + wc * 32 + 8 * fq; const size_t off = (size_t)row * D + c0;
#pragma unroll
                    for (int n = 0; n < 2; ++n) { const f32x4 xv = *(const f32x4*)(out + off + 4 * n); const f32x4 gt = *(const f32x4*)(mb + c0 + 4 * n);
                        *(f32x4*)(out + off + 4 * n) = xv + gt * acc[ai][bj][m][n]; } } }
    }
};

DI void adaln_item(const Params& p, int item, LAS unsigned char* lds, float* mod) {
    const int tid = my_tid();
    LAS float* scond = (LAS float*)lds;
    LAS float* red = scond + 5 * 1024;
    for (int i = tid; i < 5 * 1024; i += NTHR) { const int b = i >> 10, k = i & 1023; const float v = b < 4 ? p.c[b * 1024 + k] : p.c_ctx[k]; scond[i] = silu_f(v); }
    __syncthreads();
    const int cl = tid & 31, kg = tid >> 5, col = item * 32 + cl;
    float a0 = 0.f, a1 = 0.f, a2 = 0.f, a3 = 0.f, a4 = 0.f;
    for (int k8 = 0; k8 < 64; k8 += 8) { float wv[8];
#pragma unroll
        for (int u = 0; u < 8; ++u) wv[u] = p.w_mod[(size_t)(kg * 64 + k8 + u) * 6144 + col];
#pragma unroll
        for (int u = 0; u < 8; ++u) { const int k = kg * 64 + k8 + u; const float w = wv[u];
            a0 += scond[k] * w; a1 += scond[1024 + k] * w; a2 += scond[2048 + k] * w; a3 += scond[3072 + k] * w; a4 += scond[4096 + k] * w; } }
    LAS float* rp = red + (kg * 32 + cl) * 5; rp[0] = a0; rp[1] = a1; rp[2] = a2; rp[3] = a3; rp[4] = a4;
    __syncthreads();
    if (tid < 160) { const int b = tid >> 5, c2 = tid & 31; float s_ = p.b_mod[item * 32 + c2];
#pragma unroll
        for (int g = 0; g < 16; ++g) s_ += red[(g * 32 + c2) * 5 + b];
        mod[b * 6144 + item * 32 + c2] = s_; }
    __syncthreads();
}
DI void transpose_item(const float* src, int ldn, bf16_t* dst, int K, int k0, int n0, int which, LAS unsigned char* lds) {
    const int tid = my_tid(); LAS float* t = (LAS float*)lds;
#pragma unroll
    for (int i = 0; i < 2; ++i) { const int kk = (tid >> 4) + 32 * i, nn = (tid & 15) * 4, n = n0 + nn; const int sc = srccol(which, n);
        f32x4 v = sc >= 0 ? *(const f32x4*)(src + (size_t)(k0 + kk) * ldn + sc) : (f32x4){0.f, 0.f, 0.f, 0.f}; if (which == 0 && n < 256) v = v * 0.125f;
        *(LAS f32x4*)(t + kk * 68 + nn) = v; }
    __syncthreads();
    { const int nn = tid >> 3, kc = tid & 7; u32x4 w;
      w.x = pk_bf16(t[(kc * 8 + 0) * 68 + nn], t[(kc * 8 + 1) * 68 + nn]); w.y = pk_bf16(t[(kc * 8 + 2) * 68 + nn], t[(kc * 8 + 3) * 68 + nn]);
      w.z = pk_bf16(t[(kc * 8 + 4) * 68 + nn], t[(kc * 8 + 5) * 68 + nn]); w.w = pk_bf16(t[(kc * 8 + 6) * 68 + nn], t[(kc * 8 + 7) * 68 + nn]);
      *(u32x4*)(dst + (size_t)(n0 + nn) * K + k0 + kc * 8) = w; }
    __syncthreads();
}
DI void phase0(const Params& p, LAS unsigned char* lds) {
    unsigned char* ws = p.ws; const int tid = my_tid();
    float* mod = (float*)(ws + WS_MOD);
    constexpr int N_ADA = 192, T_IN = 16 * 52, T_OUT = 16 * 16, T_F1 = 16 * 88, T_F2 = 44 * 16, N_ZERO = 27;
    constexpr int O1 = N_ADA, O2 = O1 + T_IN, O3 = O2 + T_OUT, O4 = O3 + T_F1, O5 = O4 + T_F2, O6 = O5 + 1, TOT = O6 + N_ZERO;
    for (int it = blockIdx.x; it < TOT; it += gridDim.x) {
        if (it < O1) adaln_item(p, it, lds, mod);
        else if (it < O2) { const int j = it - O1; transpose_item(p.w_in, 3104, (bf16_t*)(ws + WS_WIN), D, (j & 15) * 64, (j >> 4) * 64, 0, lds); }
        else if (it < O3) { const int j = it - O2; transpose_item(p.w_out, D, (bf16_t*)(ws + WS_WOUT), D, (j & 15) * 64, (j >> 4) * 64, 1, lds); }
        else if (it < O4) { const int j = it - O3; transpose_item(p.w_ffn_in, FH2, (bf16_t*)(ws + WS_WF1), D, (j & 15) * 64, (j >> 4) * 64, 2, lds); }
        else if (it < O5) { const int j = it - O4; transpose_item(p.w_ffn_out, D, (bf16_t*)(ws + WS_WF2), FH, (j % 44) * 64, (j / 44) * 64, 3, lds); }
        else if (it < O6) {
            f32x2* tab = (f32x2*)(ws + WS_ROPE);
            for (int idx = tid; idx < 2048; idx += NTHR) { const int pos = idx >> 4, f = idx & 15; const float inv = powf(10000.0f, -(float)f / 16.0f); const float ang = (float)pos * inv;
                tab[idx] = (f32x2){cosf(ang), sinf(ang)}; }
            if (tid == 0) { float s0 = 0.f, s1 = 0.f, mq = 0.f, mk = 0.f;
                for (int i = 0; i < 64; ++i) { s0 += p.lam_q[i] * p.lam_k[i]; s1 += p.lam_q[64 + i] * p.lam_k[64 + i]; mq = fmaxf(mq, fabsf(p.q_norm_g[i])); mk = fmaxf(mk, fabsf(p.k_norm_g[i])); }
                float* ctl = (float*)(ws + WS_CTL); ctl[0] = expf(s0) - expf(s1) + 0.2f;
                ctl[1] = 8.0f * 1.4426950409f * mq * mk * 1.02f + 0.25f; }
        } else { const int j = it - O6; const int idx = j * 2048 + tid * 4;
            if (idx < NLAT) *(f32x4*)((float*)(ws + WS_ROWSS) + idx) = (f32x4){0.f, 0.f, 0.f, 0.f};
            else if (idx - NLAT < NB * FH2) *(f32x4*)((float*)(ws + WS_BIAS2) + (idx - NLAT)) = (f32x4){0.f, 0.f, 0.f, 0.f}; }
    }
}

DI void phase1(const Params& p) {
    unsigned char* ws = p.ws; const int tid = my_tid(), lane = tid & 63, wave = tid >> 6;
    const float* mod = (const float*)(ws + WS_MOD); bf16_t* H = (bf16_t*)(ws + WS_H); float* bias2 = (float*)(ws + WS_BIAS2);
    constexpr int N_ROW = NT / 16, N_B2 = 22 * 16;
    for (int it = blockIdx.x; it < N_ROW + N_B2; it += gridDim.x) {
        if (it < N_ROW) {
            const float* src[2]; const float* mb[2]; f32x4 v[2][4]; float ss[2];
#pragma unroll
            for (int u = 0; u < 2; ++u) { const int row = it * 16 + wave * 2 + u;
                if (row < NLAT) { src[u] = p.x + (size_t)row * D; mb[u] = mod + (row >> 13) * 6144; } else { src[u] = p.ctx + (size_t)(row - NLAT) * D; mb[u] = mod + 4 * 6144; }
#pragma unroll
                for (int i = 0; i < 4; ++i) v[u][i] = *(const f32x4*)(src[u] + 4 * lane + 256 * i); }
#pragma unroll
            for (int u = 0; u < 2; ++u) { ss[u] = 0.f;
#pragma unroll
                for (int i = 0; i < 4; ++i) ss[u] += (v[u][i][0] * v[u][i][0] + v[u][i][1] * v[u][i][1]) + (v[u][i][2] * v[u][i][2] + v[u][i][3] * v[u][i][3]);
                ss[u] = wave_allreduce_sum(ss[u]); }
#pragma unroll
            for (int u = 0; u < 2; ++u) { const int row = it * 16 + wave * 2 + u; const float rs = rsqrtf(ss[u] * (1.0f / 1024.0f) + EPS);
#pragma unroll
                for (int i = 0; i < 4; ++i) { const int c = 4 * lane + 256 * i; const f32x4 g = *(const f32x4*)(p.norm1_g + c), sh = *(const f32x4*)(mb[u] + c), sc = *(const f32x4*)(mb[u] + 1024 + c);
                    const f32x4 h = v[u][i] * rs * g * (sc + 1.0f) + sh; u32x2 w; w.x = pk_bf16(h[0], h[1]); w.y = pk_bf16(h[2], h[3]); *(u32x2*)(H + (size_t)row * D + c) = w; } }
        } else {
            const int idx = it - N_ROW, nb = idx % 22, kc = idx / 22; const int nn = tid & 255, half = tid >> 8; const int n = nb * 256 + nn, sc = srccol(2, n);
            float a0 = 0.f, a1 = 0.f, a2 = 0.f, a3 = 0.f;
            for (int kk = 0; kk < 32; ++kk) { const int k = kc * 64 + half * 32 + kk; const float w = p.w_ffn_in[(size_t)k * FH2 + sc];
                a0 += mod[3072 + k] * w; a1 += mod[6144 + 3072 + k] * w; a2 += mod[2 * 6144 + 3072 + k] * w; a3 += mod[3 * 6144 + 3072 + k] * w; }
            atomicAdd(bias2 + n, a0); atomicAdd(bias2 + FH2 + n, a1); atomicAdd(bias2 + 2 * FH2 + n, a2); atomicAdd(bias2 + 3 * FH2 + n, a3);
        }
    }
}

#define DPPF(x, ctrl) __builtin_bit_cast(float, __builtin_amdgcn_update_dpp(0, __builtin_bit_cast(int, (x)), (ctrl), 0xf, 0xf, false))
DI void qknorm_item(const Params& p, int item) {
    unsigned char* ws = p.ws; const int tid = my_tid(); bf16_t* P = (bf16_t*)(ws + WS_P); const f32x2* tab = (const f32x2*)(ws + WS_ROPE);
    const int sub = tid & 63, j = sub & 7;
    const float* gsrc = p.k_norm_g + 8 * j;
    float g[8];
#pragma unroll
    for (int e = 0; e < 8; ++e) g[e] = gsrc[e];
    const int axis = j >> 2, half = (j >> 1) & 1, f0 = 8 * (j & 1);
    u32x4 raws[8];
#pragma unroll
    for (int u = 0; u < 8; ++u) raws[u] = *(const u32x4*)(P + (size_t)(item * 64 + u * 8 + (tid >> 6)) * PW + C_DK + sub * 8);
#pragma unroll
    for (int u = 0; u < 8; ++u) {
        const int row = item * 64 + u * 8 + (tid >> 6);
        bf16_t* ptr = P + (size_t)row * PW + C_DK + sub * 8;
        const u32x4 raw = raws[u];
        float v[8]; v[0] = bf_lo(raw.x); v[1] = bf_hi(raw.x); v[2] = bf_lo(raw.y); v[3] = bf_hi(raw.y); v[4] = bf_lo(raw.z); v[5] = bf_hi(raw.z); v[6] = bf_lo(raw.w); v[7] = bf_hi(raw.w);
        float ss = 0.f;
#pragma unroll
        for (int e = 0; e < 8; ++e) ss += v[e] * v[e];
        ss += DPPF(ss, 0xB1); ss += DPPF(ss, 0x4E); ss += DPPF(ss, 0x141);
        const float rs = rsqrtf(ss * (1.0f / 64.0f) + EPS);
#pragma unroll
        for (int e = 0; e < 8; ++e) v[e] = v[e] * rs * g[e];
        if (row < NLAT) {
            const int t = row & (SEQ - 1); const int pos = axis ? (t & 63) : (t >> 6);
#pragma unroll
            for (int e = 0; e < 8; ++e) { const float o = DPPF(v[e], 0x4E); const f32x2 cs = tab[pos * 16 + f0 + e];
                v[e] = half ? (v[e] * cs.x + o * cs.y) : (v[e] * cs.x - o * cs.y); }
        }
        u32x4 w; w.x = pk_bf16(v[0], v[1]); w.y = pk_bf16(v[2], v[3]); w.z = pk_bf16(v[4], v[5]); w.w = pk_bf16(v[6], v[7]);
        *(u32x4*)ptr = w;
    }
}


#define DPP_ADD(x, ctrl) ((x) + __builtin_bit_cast(float, __builtin_amdgcn_update_dpp(0, __builtin_bit_cast(int, (x)), (ctrl), 0xf, 0xf, false)))
DI float scan_prefix64(float x, int lane) {
    x = DPP_ADD(x, 0x111); x = DPP_ADD(x, 0x112); x = DPP_ADD(x, 0x114); x = DPP_ADD(x, 0x118);
    x += __builtin_bit_cast(float, __builtin_amdgcn_update_dpp(0, __builtin_bit_cast(int, x), 0x142, 0xa, 0xf, false));
    x += __builtin_bit_cast(float, __builtin_amdgcn_update_dpp(0, __builtin_bit_cast(int, x), 0x143, 0xc, 0xf, false));
    return x;
}
DI float scan_suffix64(float x, int lane) {
    const float pre = scan_prefix64(x, lane);
    const float tot = __builtin_bit_cast(float, __builtin_amdgcn_readlane(__builtin_bit_cast(int, pre), 63));
    return (tot - pre) + x;
}
#define GLA_GATES(dir, g)                                                                                                           \
    do {                                                                                                                           \
        f32x2 z2_[4];                                                                                                               \
        _Pragma("unroll") for (int c2 = 0; c2 < 4; ++c2) z2_[c2] = *(const f32x2*)(p.gate_bias + (dir) * 256 + h * 64 + ch0 + 2 * c2) * 1.4426950409f; \
        _Pragma("unroll") for (int rr = 0; rr < 16; ++rr) {                                                                         \
            const f32x4 ga_ = *(const LAS f32x4*)(GU + ((dir) * 16 + rr) * 64 + ch0), gb_ = *(const LAS f32x4*)(GU + ((dir) * 16 + rr) * 64 + ch0 + 4); \
            const f32x2 dv_ = {dn[(dir) * 16 + rr], dn[(dir) * 16 + rr]};                                                           \
            z2_[0] += dv_ * (f32x2){ga_[0], ga_[1]}; z2_[1] += dv_ * (f32x2){ga_[2], ga_[3]};                                       \
            z2_[2] += dv_ * (f32x2){gb_[0], gb_[1]}; z2_[3] += dv_ * (f32x2){gb_[2], gb_[3]};                                       \
        }                                                                                                                          \
        _Pragma("unroll") for (int c = 0; c < 8; ++c) g[c] = logsig2_16(z2_[c >> 1][c & 1]);                                        \
        _Pragma("unroll") for (int c = 0; c < 8; ++c) g[c] = (dir) == 0 ? scan_prefix64(g[c], lane) : scan_suffix64(g[c], lane);             \
    } while (0)

DI void gla_a_pair(const Params& p, LAS unsigned char* lds0, int jA, int jB) {
    unsigned char* ws = p.ws; const int tid = my_tid(), lane = tid & 63, wave = __builtin_amdgcn_readfirstlane(tid >> 6);
    const int half = wave >> 2, w4 = wave & 3, tidh = tid & 255;
    const int j = half ? jB : jA; const int b = j / (4 * NPOS), h = (j / NPOS) & 3, cc = j % NPOS;
    LAS unsigned char* lds = lds0 + half * 53248;
    const bf16_t* P = (const bf16_t*)(ws + WS_P); const float* GDp = (const float*)(ws + WS_GD); bf16_t* DS = (bf16_t*)(ws + WS_DS); float* DEC = (float*)(ws + WS_DEC);
    const int row0 = cc < 4 ? NLAT + b * CTXL + cc * 64 : b * SEQ + (cc - 4) * 64;
    LAS float* GU = (LAS float*)lds;
    LAS unsigned char* KI0 = lds + 8192;
    LAS unsigned char* KI1 = lds + 8192 + 12288;
    LAS unsigned char* VI = lds + 8192 + 24576;
#pragma unroll
    for (int i = 0; i < 8; ++i) { const int idx = tidh + 256 * i; const int dir = idx >> 10, rr = (idx >> 6) & 15, c = idx & 63; GU[idx] = p.gate_up[(dir * 16 + rr) * 256 + h * 64 + c] * 1.4426950409f; }
#pragma unroll
    for (int i = 0; i < 4; ++i) { const int id = tidh + 256 * i, row = id >> 4, c16 = id & 15;
        *(LAS u32x4*)(VI + row * 320 + c16 * 16) = *(const u32x4*)(P + (size_t)(row0 + row) * PW + C_GV + h * 128 + c16 * 8); }
    float dn[32];
#pragma unroll
    for (int i = 0; i < 8; ++i) { const f32x4 t = *(const f32x4*)(GDp + (size_t)(row0 + lane) * 32 + 4 * i); dn[4 * i] = t[0]; dn[4 * i + 1] = t[1]; dn[4 * i + 2] = t[2]; dn[4 * i + 3] = t[3]; }
    u32x4 kraw2[2], qraw2[2];
#pragma unroll
    for (int cb = 0; cb < 2; ++cb) { kraw2[cb] = *(const u32x4*)(P + (size_t)(row0 + lane) * PW + C_GK + h * 64 + 16 * w4 + 8 * cb);
        qraw2[cb] = *(const u32x4*)(P + (size_t)(row0 + lane) * PW + (cc >= 4 ? C_GQ : C_GK) + h * 64 + 16 * w4 + 8 * cb); }
    __syncthreads();
    const int seq0 = (b * 4 + h) * 2;
    const int pos0 = cc, pos1 = cc < 4 ? 3 - cc : 135 - cc;
#pragma unroll
    for (int cb = 0; cb < 2; ++cb) {
        const int ch0 = 16 * w4 + 8 * cb;
        const u32x4 kraw = kraw2[cb], qraw = qraw2[cb];
        float kf[8]; kf[0] = bf_lo(kraw.x); kf[1] = bf_hi(kraw.x); kf[2] = bf_lo(kraw.y); kf[3] = bf_hi(kraw.y); kf[4] = bf_lo(kraw.z); kf[5] = bf_hi(kraw.z); kf[6] = bf_lo(kraw.w); kf[7] = bf_hi(kraw.w);
        float qf8[8]; qf8[0] = bf_lo(qraw.x); qf8[1] = bf_hi(qraw.x); qf8[2] = bf_lo(qraw.y); qf8[3] = bf_hi(qraw.y); qf8[4] = bf_lo(qraw.z); qf8[5] = bf_hi(qraw.z); qf8[6] = bf_lo(qraw.w); qf8[7] = bf_hi(qraw.w);
        bf16_t* QKT = (bf16_t*)(ws + WS_H) + ((size_t)((b * 4 + h) * 128 + (cc - 4)) * 4) * 4096 + lane * 64 + ch0;
#pragma unroll
        for (int dir = 0; dir < 2; ++dir) {
            float g[8]; GLA_GATES(dir, g);
            float kh[8];
            float eg[8], ieg[8], et[8];
#pragma unroll
            for (int c = 0; c < 8; ++c) { const float tot = __builtin_bit_cast(float, __builtin_amdgcn_readlane(__builtin_bit_cast(int, g[c]), dir == 0 ? 63 : 0)); et[c] = __builtin_amdgcn_exp2f(tot); eg[c] = __builtin_amdgcn_exp2f(g[c]); ieg[c] = __builtin_amdgcn_exp2f(fminf(-g[c], 86.0f)); kh[c] = (kf[c] * ieg[c]) * et[c]; }
            if (lane == 0) { float* dp = DEC + ((size_t)(seq0 + dir) * NPOS + (dir == 0 ? pos0 : pos1)) * 64 + ch0;
                *(f32x4*)dp = (f32x4){et[0], et[1], et[2], et[3]}; *(f32x4*)(dp + 4) = (f32x4){et[4], et[5], et[6], et[7]}; }
            u32x4 w; w.x = pk_bf16(kh[0], kh[1]); w.y = pk_bf16(kh[2], kh[3]); w.z = pk_bf16(kh[4], kh[5]); w.w = pk_bf16(kh[6], kh[7]);
            *(LAS u32x4*)((dir == 0 ? KI0 : KI1) + lane * 192 + ch0 * 2) = w;
            if (cc >= 4) {
                float qt[8], kt[8];
#pragma unroll
                for (int c = 0; c < 8; ++c) { qt[c] = qf8[c] * eg[c]; kt[c] = kf[c] * ieg[c]; }
                u32x4 wq, wk; wq.x = pk_bf16(qt[0], qt[1]); wq.y = pk_bf16(qt[2], qt[3]); wq.z = pk_bf16(qt[4], qt[5]); wq.w = pk_bf16(qt[6], qt[7]);
                wk.x = pk_bf16(kt[0], kt[1]); wk.y = pk_bf16(kt[2], kt[3]); wk.z = pk_bf16(kt[4], kt[5]); wk.w = pk_bf16(kt[6], kt[7]);
                *(u32x4*)(QKT + (dir * 2 + 0) * 4096) = wq; *(u32x4*)(QKT + (dir * 2 + 1) * 4096) = wk;
            }
        }
    }
    __syncthreads();
    const int r = lane & 31, hh = lane >> 5, q = (lane & 15) >> 2, pc = lane & 3, blk = (lane >> 4) & 1;
    const int dkt = w4 & 1, dv2 = (w4 >> 1) * 2;
    f32x16 af0 = {}, af1 = {}, ab0 = {}, ab1 = {};
#pragma unroll
    for (int s_ = 0; s_ < 4; ++s_) {
        const bf16x8 b0 = tr_frag(VI + (16 * s_ + 8 * hh + q) * 320 + dv2 * 64 + 32 * blk + 8 * pc, 4 * 320);
        const bf16x8 b1 = tr_frag(VI + (16 * s_ + 8 * hh + q) * 320 + (dv2 + 1) * 64 + 32 * blk + 8 * pc, 4 * 320);
        const bf16x8 a0 = tr_frag(KI0 + (16 * s_ + 8 * hh + q) * 192 + dkt * 64 + 32 * blk + 8 * pc, 4 * 192);
        const bf16x8 a1 = tr_frag(KI1 + (16 * s_ + 8 * hh + q) * 192 + dkt * 64 + 32 * blk + 8 * pc, 4 * 192);
        af0 = MFMA32(a0, b0, af0); af1 = MFMA32(a0, b1, af1); ab0 = MFMA32(a1, b0, ab0); ab1 = MFMA32(a1, b1, ab1);
    }
    bf16_t* o0 = DS + ((size_t)(seq0 + 0) * NPOS + pos0) * 8192 + (dkt * 32) * 128 + dv2 * 32 + r;
    bf16_t* o1 = DS + ((size_t)(seq0 + 1) * NPOS + pos1) * 8192 + (dkt * 32) * 128 + dv2 * 32 + r;
#pragma unroll
    for (int i = 0; i < 16; ++i) { const int dk = crow(i, hh);
        const unsigned wf = pk_bf16(af0[i], af1[i]), wb = pk_bf16(ab0[i], ab1[i]);
        o0[dk * 128] = (bf16_t)(wf & 0xffffu); o0[dk * 128 + 32] = (bf16_t)(wf >> 16);
        o1[dk * 128] = (bf16_t)(wb & 0xffffu); o1[dk * 128 + 32] = (bf16_t)(wb >> 16); }
    __syncthreads();
}

DI void gla_b(const Params& p) {
    unsigned char* ws = p.ws; unsigned* DS = (unsigned*)(ws + WS_DS); const float* DEC = (const float*)(ws + WS_DEC);
    const int nthr = gridDim.x * NTHR;
    for (int e = blockIdx.x * NTHR + my_tid(); e < 32 * 64 * 64; e += nthr) {
        const int seq = e >> 12, dk = (e >> 6) & 63, dvp = e & 63;
        unsigned* base = DS + (size_t)seq * NPOS * 4096 + dk * 64 + dvp; const float* dec = DEC + (size_t)seq * NPOS * 64 + dk;
        float s0 = 0.f, s1 = 0.f;
        for (int pp = 0; pp < NPOS; pp += 12) {
            unsigned raw[12]; float d[12];
#pragma unroll
            for (int u = 0; u < 12; ++u) { raw[u] = base[(size_t)(pp + u) * 4096]; d[u] = dec[(pp + u) * 64]; }
#pragma unroll
            for (int u = 0; u < 12; ++u) { base[(size_t)(pp + u) * 4096] = pk_bf16(s0, s1); s0 = d[u] * s0 + bf_lo(raw[u]); s1 = d[u] * s1 + bf_hi(raw[u]); }
        }
    }
}

DI void gla_c_item(const Params& p, LAS unsigned char* lds, int b, int h, int c) {
    unsigned char* ws = p.ws; const int tid = my_tid(), lane = tid & 63, wave = __builtin_amdgcn_readfirstlane(tid >> 6);
    const bf16_t* P = (const bf16_t*)(ws + WS_P); const float* GDp = (const float*)(ws + WS_GD); const bf16_t* DS = (const bf16_t*)(ws + WS_DS); bf16_t* MIX = (bf16_t*)(ws + WS_MIX);
    const int row0 = b * SEQ + c * 64; const int ch0 = 8 * wave;
    LAS float* GU = (LAS float*)lds;
    LAS unsigned char* QI0 = lds + 8192;
    LAS unsigned char* KI0 = lds + 8192 + 9216;
    LAS unsigned char* QI1 = lds + 8192 + 2 * 9216;
    LAS unsigned char* KI1 = lds + 8192 + 3 * 9216;
    LAS unsigned char* VI = lds + 45056;
    LAS unsigned char* SI0 = lds + 65536;
    LAS unsigned char* SI1 = lds + 86016;
    LAS float* RED = (LAS float*)(lds + 106496);
    const int seq0 = (b * 4 + h) * 2; const int pos0 = c + 4, pos1 = 131 - c;
    const bf16_t* s0p = DS + ((size_t)(seq0 + 0) * NPOS + pos0) * 8192; const bf16_t* s1p = DS + ((size_t)(seq0 + 1) * NPOS + pos1) * 8192;
    const bf16_t* QKT = (const bf16_t*)(ws + WS_H) + ((size_t)((b * 4 + h) * 128 + c) * 4) * 4096;
#pragma unroll
    for (int i = 0; i < 2; ++i) { const int id = tid + NTHR * i, row = id >> 4, c16 = id & 15;
        *(LAS u32x4*)(VI + row * 320 + c16 * 16) = *(const u32x4*)(P + (size_t)(row0 + row) * PW + C_GV + h * 128 + c16 * 8);
        *(LAS u32x4*)(SI0 + row * 320 + c16 * 16) = *(const u32x4*)(s0p + row * 128 + c16 * 8);
        *(LAS u32x4*)(SI1 + row * 320 + c16 * 16) = *(const u32x4*)(s1p + row * 128 + c16 * 8); }
    { const int row = tid >> 3, c8 = tid & 7;
      *(LAS u32x4*)(QI0 + row * 144 + c8 * 16) = *(const u32x4*)(QKT + 0 * 4096 + row * 64 + c8 * 8);
      *(LAS u32x4*)(KI0 + row * 144 + c8 * 16) = *(const u32x4*)(QKT + 1 * 4096 + row * 64 + c8 * 8);
      *(LAS u32x4*)(QI1 + row * 144 + c8 * 16) = *(const u32x4*)(QKT + 2 * 4096 + row * 64 + c8 * 8);
      *(LAS u32x4*)(KI1 + row * 144 + c8 * 16) = *(const u32x4*)(QKT + 3 * 4096 + row * 64 + c8 * 8); }
    const int r = lane & 31, hh = lane >> 5, q = (lane & 15) >> 2, pc = lane & 3, blk = (lane >> 4) & 1;
    const int it = wave & 1, dvt = wave >> 1;
    const size_t rowg = (size_t)(row0 + 32 * it + r);
    u32x2 rgate[4];
#pragma unroll
    for (int gi = 0; gi < 4; ++gi) rgate[gi] = *(const u32x2*)(P + rowg * PW + C_GR + h * 128 + 32 * dvt + 8 * gi + 4 * hh);
    __syncthreads();
    f32x16 O = {};
#pragma unroll
    for (int dir = 0; dir < 2; ++dir) {
        const LAS unsigned char* QI = dir == 0 ? QI0 : QI1; const LAS unsigned char* KI = dir == 0 ? KI0 : KI1; const LAS unsigned char* SI = dir == 0 ? SI0 : SI1;
        bf16x8 qfr[4];
#pragma unroll
        for (int ks = 0; ks < 4; ++ks) qfr[ks] = *(const LAS bf16x8*)(QI + (32 * it + r) * 144 + (16 * ks + 8 * hh) * 2);
#pragma unroll
        for (int jt = 0; jt < 2; ++jt) {
            f32x16 X = {};
#pragma unroll
            for (int ks = 0; ks < 4; ++ks) { const bf16x8 a = *(const LAS bf16x8*)(KI + (32 * jt + r) * 144 + (16 * ks + 8 * hh) * 2); X = MFMA32(a, qfr[ks], X); }
            const int itok = 32 * it + r;
#pragma unroll
            for (int i = 0; i < 16; ++i) { const int jtok = 32 * jt + crow(i, hh); const bool keep = dir == 0 ? (jtok <= itok) : (jtok >= itok); X[i] = keep ? X[i] : 0.f; }
            u32x4 w0, w1; w0.x = pk_bf16(X[0], X[1]); w0.y = pk_bf16(X[2], X[3]); w0.z = pk_bf16(X[4], X[5]); w0.w = pk_bf16(X[6], X[7]);
            w1.x = pk_bf16(X[8], X[9]); w1.y = pk_bf16(X[10], X[11]); w1.z = pk_bf16(X[12], X[13]); w1.w = pk_bf16(X[14], X[15]);
            const bf16x8 pb0 = __builtin_bit_cast(bf16x8, w0), pb1 = __builtin_bit_cast(bf16x8, w1);
            const bf16x8 v0 = tr_frag(VI + (32 * jt + 4 * hh + q) * 320 + dvt * 64 + 32 * blk + 8 * pc, 8 * 320);
            const bf16x8 v1 = tr_frag(VI + (32 * jt + 16 + 4 * hh + q) * 320 + dvt * 64 + 32 * blk + 8 * pc, 8 * 320);
            O = MFMA32(v0, pb0, O); O = MFMA32(v1, pb1, O);
        }
#pragma unroll
        for (int ks = 0; ks < 4; ++ks) { const bf16x8 a3 = tr_frag(SI + (16 * ks + 8 * hh + q) * 320 + dvt * 64 + 32 * blk + 8 * pc, 4 * 320); O = MFMA32(a3, qfr[ks], O); }
    }
    float ss = 0.f;
#pragma unroll
    for (int i = 0; i < 16; ++i) ss += O[i] * O[i];
    ss += __shfl_xor(ss, 32);
    if (lane < 32) RED[(it * 4 + dvt) * 32 + r] = ss;
    __syncthreads();
    const float tot = (RED[(it * 4 + 0) * 32 + r] + RED[(it * 4 + 1) * 32 + r]) + (RED[(it * 4 + 2) * 32 + r] + RED[(it * 4 + 3) * 32 + r]);
    const float rs = rsqrtf(tot * (1.0f / 128.0f) + EPS);
#pragma unroll
    for (int gi = 0; gi < 4; ++gi) { const int dv0 = 32 * dvt + 8 * gi + 4 * hh;
        const u32x2 rr = rgate[gi]; const f32x4 gn = *(const f32x4*)(p.gla_norm_g + dv0);
        const float o0 = O[4 * gi] * rs * gn[0] * silu_f(bf_lo(rr.x)), o1 = O[4 * gi + 1] * rs * gn[1] * silu_f(bf_hi(rr.x));
        const float o2 = O[4 * gi + 2] * rs * gn[2] * silu_f(bf_lo(rr.y)), o3 = O[4 * gi + 3] * rs * gn[3] * silu_f(bf_hi(rr.y));
        u32x2 w; w.x = pk_bf16(o0, o1); w.y = pk_bf16(o2, o3); *(u32x2*)(MIX + rowg * D + h * 128 + dv0) = w; }
    __syncthreads();
}

constexpr int ATT_KB = 64 * 272, ATT_VB = 64 * 320, ATT_BUF = ATT_KB + ATT_VB;
DI void att_stage(f32x16& Snew, const f32x16& Sold, const LAS unsigned char* Kp, const LAS unsigned char* Vp, const bf16x8 (&qf)[4], const float negM, f32x16 (&acc)[4], float& lsum) {
    float pe[16];
#pragma unroll
    for (int i = 0; i < 16; ++i) Snew[i] = negM;
    { const bf16x8 a = *(const LAS bf16x8*)(Kp); Snew = MFMA32(a, qf[0], Snew); }
#pragma unroll
    for (int i = 0; i < 4; ++i) pe[i] = __builtin_amdgcn_exp2f(Sold[i]);
    { const bf16x8 a = *(const LAS bf16x8*)(Kp + 32); Snew = MFMA32(a, qf[1], Snew); }
#pragma unroll
    for (int i = 4; i < 8; ++i) pe[i] = __builtin_amdgcn_exp2f(Sold[i]);
    { const bf16x8 a = *(const LAS bf16x8*)(Kp + 64); Snew = MFMA32(a, qf[2], Snew); }
#pragma unroll
    for (int i = 8; i < 12; ++i) pe[i] = __builtin_amdgcn_exp2f(Sold[i]);
    { const bf16x8 a = *(const LAS bf16x8*)(Kp + 96); Snew = MFMA32(a, qf[3], Snew); }
#pragma unroll
    for (int i = 12; i < 16; ++i) pe[i] = __builtin_amdgcn_exp2f(Sold[i]);
    lsum += ((pe[0] + pe[1]) + (pe[2] + pe[3])) + ((pe[4] + pe[5]) + (pe[6] + pe[7])) + ((pe[8] + pe[9]) + (pe[10] + pe[11])) + ((pe[12] + pe[13]) + (pe[14] + pe[15]));
    u32x4 w0, w1; w0.x = pk_bf16(pe[0], pe[1]); w0.y = pk_bf16(pe[2], pe[3]); w0.z = pk_bf16(pe[4], pe[5]); w0.w = pk_bf16(pe[6], pe[7]);
    w1.x = pk_bf16(pe[8], pe[9]); w1.y = pk_bf16(pe[10], pe[11]); w1.z = pk_bf16(pe[12], pe[13]); w1.w = pk_bf16(pe[14], pe[15]);
    const bf16x8 pb0 = __builtin_bit_cast(bf16x8, w0), pb1 = __builtin_bit_cast(bf16x8, w1);
#pragma unroll
    for (int t = 0; t < 4; ++t) { const bf16x8 v0 = tr_frag(Vp + t * 64, 8 * 320); acc[t] = MFMA32(v0, pb0, acc[t]); }
#pragma unroll
    for (int t = 0; t < 4; ++t) { const bf16x8 v1 = tr_frag(Vp + 16 * 320 + t * 64, 8 * 320); acc[t] = MFMA32(v1, pb1, acc[t]); }
}
struct BScan { unsigned* base; const float* dec; float s0, s1; unsigned raw; float d; int step; };
DI void bscan_init(const Params& p, BScan& B) {
    unsigned char* ws = p.ws; const int e = blockIdx.x * NTHR + my_tid();
    const int seq = e >> 12, dk = (e >> 6) & 63, dvp = e & 63;
    B.base = (unsigned*)(ws + WS_DS) + (size_t)seq * NPOS * 4096 + dk * 64 + dvp; B.dec = (const float*)(ws + WS_DEC) + (size_t)seq * NPOS * 64 + dk;
    B.s0 = 0.f; B.s1 = 0.f; B.raw = 0u; B.d = 0.f; B.step = 0;
}
DI void bscan_top(BScan& B) {
    if ((B.step & 3) == 0) { const int pp = B.step >> 2; B.raw = B.base[(size_t)pp * 4096]; B.d = B.dec[pp * 64]; B.base[(size_t)pp * 4096] = pk_bf16(B.s0, B.s1); }
}
DI void bscan_bottom(BScan& B) {
    if ((B.step & 3) == 0) { B.s0 = B.d * B.s0 + bf_lo(B.raw); B.s1 = B.d * B.s1 + bf_hi(B.raw); }
    ++B.step;
}
template <bool FUSEB>
DI void attn_unit(const Params& p, LAS unsigned char* lds, int b, int h, int qblk, float Mshift, float lam, int trot, BScan& BS) {
    unsigned char* ws = p.ws; const int tid = my_tid(), lane = tid & 63, wave = __builtin_amdgcn_readfirstlane(tid >> 6);
    const bf16_t* P = (const bf16_t*)(ws + WS_P); bf16_t* MIX = (bf16_t*)(ws + WS_MIX);
    const int r = lane & 31, hh = lane >> 5, q = (lane & 15) >> 2, pc = lane & 3, blk = (lane >> 4) & 1;
    const int comp = wave >> 2, wq = wave & 3;
    const size_t qrow = (size_t)b * SEQ + qblk * 128 + wq * 32 + r;
    bf16x8 qf[4];
    {
        const f32x2* tab = (const f32x2*)(ws + WS_ROPE);
        u32x4 qraw[4];
#pragma unroll
        for (int ks = 0; ks < 4; ++ks) qraw[ks] = *(const u32x4*)(P + qrow * PW + C_DQ + h * 128 + comp * 64 + ks * 16 + hh * 8);
        float y[4][8]; float ss = 0.f;
#pragma unroll
        for (int ks = 0; ks < 4; ++ks) { y[ks][0] = bf_lo(qraw[ks].x); y[ks][1] = bf_hi(qraw[ks].x); y[ks][2] = bf_lo(qraw[ks].y); y[ks][3] = bf_hi(qraw[ks].y);
            y[ks][4] = bf_lo(qraw[ks].z); y[ks][5] = bf_hi(qraw[ks].z); y[ks][6] = bf_lo(qraw[ks].w); y[ks][7] = bf_hi(qraw[ks].w);
#pragma unroll
            for (int j = 0; j < 8; ++j) ss += y[ks][j] * y[ks][j]; }
        ss += __shfl_xor(ss, 32);
        const float rs = rsqrtf(ss * (1.0f / 64.0f) + EPS) * (0.125f * 1.4426950409f);
#pragma unroll
        for (int ks = 0; ks < 4; ++ks)
#pragma unroll
            for (int j = 0; j < 8; ++j) y[ks][j] *= rs * p.q_norm_g[ks * 16 + hh * 8 + j];
        const int tq = qblk * 128 + wq * 32 + r;
#pragma unroll
        for (int ax = 0; ax < 2; ++ax) { const int pos = ax ? (tq & 63) : (tq >> 6);
#pragma unroll
            for (int j = 0; j < 8; ++j) { const f32x2 cs = tab[pos * 16 + hh * 8 + j]; const float x1 = y[2 * ax][j], x2 = y[2 * ax + 1][j];
                y[2 * ax][j] = x1 * cs.x - x2 * cs.y; y[2 * ax + 1][j] = x2 * cs.x + x1 * cs.y; } }
#pragma unroll
        for (int ks = 0; ks < 4; ++ks) { u32x4 w; w.x = pk_bf16(y[ks][0], y[ks][1]); w.y = pk_bf16(y[ks][2], y[ks][3]); w.z = pk_bf16(y[ks][4], y[ks][5]); w.w = pk_bf16(y[ks][6], y[ks][7]);
            qf[ks] = __builtin_bit_cast(bf16x8, w); }
    }
    f32x16 acc[4];
#pragma unroll
    for (int t = 0; t < 4; ++t)
#pragma unroll
        for (int i = 0; i < 16; ++i) acc[t][i] = 0.f;
    const float negM = -Mshift;
    float lsum = 0.f;
    const int ldr = tid >> 4, ldc = tid & 15;
    const int koff = (r) * 272 + comp * 128 + hh * 16;
    const int voff = ATT_KB + (4 * hh + q) * 320 + 32 * blk + 8 * pc;
    u32x4 kreg[2], vreg[2];
#define ATT_GROW(kt, row) ((kt) < 4 ? (size_t)(NLAT + b * CTXL + (kt) * 64 + (row)) : (size_t)(b * SEQ + ((kt) - 4) * 64 + (row)))
#define ATT_LOAD(kr, vr, kt0) do { int kt_ = (kt0) + trot; kt_ = kt_ >= NPOS ? kt_ - NPOS : kt_; _Pragma("unroll") for (int i_ = 0; i_ < 2; ++i_) { const bf16_t* g_ = P + ATT_GROW(kt_, ldr + 32 * i_) * PW + h * 128 + ldc * 8; \
        kr[i_] = *(const u32x4*)(g_ + C_DK); vr[i_] = *(const u32x4*)(g_ + C_DV); } } while (0)
#define ATT_STORE(kr, vr, bufp) do { _Pragma("unroll") for (int i_ = 0; i_ < 2; ++i_) { *(LAS u32x4*)((bufp) + (ldr + 32 * i_) * 272 + ldc * 16) = kr[i_]; \
        *(LAS u32x4*)((bufp) + ATT_KB + (ldr + 32 * i_) * 320 + ldc * 16) = vr[i_]; } } while (0)
    for (int i = tid; i < ATT_VB / 16; i += NTHR) *(LAS u32x4*)(lds + 2 * ATT_BUF + ATT_KB + i * 16) = (u32x4){0u, 0u, 0u, 0u};
    ATT_LOAD(kreg, vreg, 0); ATT_STORE(kreg, vreg, lds);
    __syncthreads();
    f32x16 S0, S1;
#pragma unroll
    for (int i = 0; i < 16; ++i) { S1[i] = -1.0e30f; S0[i] = 0.f; }
    int cur = 0, prv = 2, nxt = 1;
    for (int kt = 0; kt < NPOS; ++kt) {
        const LAS unsigned char* Bc = lds + cur * ATT_BUF; const LAS unsigned char* Bp = lds + prv * ATT_BUF;
        if (kt + 1 < NPOS) ATT_LOAD(kreg, vreg, kt + 1);
        if (FUSEB) bscan_top(BS);
        __builtin_amdgcn_sched_barrier(0);
        att_stage(S0, S1, Bc + koff, Bp + voff + 32 * 320, qf, negM, acc, lsum);
        att_stage(S1, S0, Bc + koff + 32 * 272, Bc + voff, qf, negM, acc, lsum);
        __builtin_amdgcn_sched_barrier(0);
        if (kt + 1 < NPOS) ATT_STORE(kreg, vreg, lds + nxt * ATT_BUF);
        if (FUSEB) bscan_bottom(BS);
        __syncthreads();
        { const int t_ = prv; prv = cur; cur = nxt; nxt = t_; }
    }
#undef ATT_GROW
#undef ATT_LOAD
#undef ATT_STORE
    {
        const LAS unsigned char* Vp = lds + prv * ATT_BUF + voff + 32 * 320;
        float pe[16];
#pragma unroll
        for (int i = 0; i < 16; ++i) { pe[i] = __builtin_amdgcn_exp2f(S1[i]); lsum += pe[i]; }
        u32x4 w0, w1; w0.x = pk_bf16(pe[0], pe[1]); w0.y = pk_bf16(pe[2], pe[3]); w0.z = pk_bf16(pe[4], pe[5]); w0.w = pk_bf16(pe[6], pe[7]);
        w1.x = pk_bf16(pe[8], pe[9]); w1.y = pk_bf16(pe[10], pe[11]); w1.z = pk_bf16(pe[12], pe[13]); w1.w = pk_bf16(pe[14], pe[15]);
        const bf16x8 pb0 = __builtin_bit_cast(bf16x8, w0), pb1 = __builtin_bit_cast(bf16x8, w1);
#pragma unroll
        for (int t = 0; t < 4; ++t) { const bf16x8 v0 = tr_frag(Vp + t * 64, 8 * 320); const bf16x8 v1 = tr_frag(Vp + 16 * 320 + t * 64, 8 * 320);
            acc[t] = MFMA32(v0, pb0, acc[t]); acc[t] = MFMA32(v1, pb1, acc[t]); }
    }
    __syncthreads();
    const float l = lsum + __shfl_xor(lsum, 32);
    const float sc = (comp ? lam : 1.0f) / l;
#pragma unroll
    for (int t = 0; t < 4; ++t)
#pragma unroll
        for (int i = 0; i < 16; ++i) acc[t][i] *= sc;
    LAS float* X = (LAS float*)lds + wq * 4096;
    if (comp == 1) {
#pragma unroll
        for (int t = 0; t < 4; ++t)
#pragma unroll
            for (int i = 0; i < 16; ++i) X[(t * 16 + i) * 64 + lane] = acc[t][i];
    }
    __syncthreads();
    if (comp == 0) {
        float ss = 0.f;
#pragma unroll
        for (int t = 0; t < 4; ++t)
#pragma unroll
            for (int i = 0; i < 16; ++i) { acc[t][i] -= X[(t * 16 + i) * 64 + lane]; ss += acc[t][i] * acc[t][i]; }
        ss += __shfl_xor(ss, 32);
        const float rs = rsqrtf(ss * (1.0f / 128.0f) + EPS) * 0.8f;
#pragma unroll
        for (int t = 0; t < 4; ++t)
#pragma unroll
            for (int gi = 0; gi < 4; ++gi) { const int dv0 = 32 * t + 8 * gi + 4 * hh; const f32x4 gn = *(const f32x4*)(p.diff_norm_g + dv0);
                u32x2 w; w.x = pk_bf16(acc[t][4 * gi] * rs * gn[0], acc[t][4 * gi + 1] * rs * gn[1]); w.y = pk_bf16(acc[t][4 * gi + 2] * rs * gn[2], acc[t][4 * gi + 3] * rs * gn[3]);
                *(u32x2*)(MIX + qrow * D + 512 + h * 128 + dv0) = w; }
    }
    __syncthreads();
}

#define XB_TMO      128
#define XB_XCNT(j)  (256  + 64 * (j))
#define XB_XSUB(j)  (1280 + 64 * (j))
#define XB_XGEN(j)  (2304 + 64 * (j))
#define XB_TOP      3328
#define XB_TOPGEN   3392
#define XCD_BAR_WORDS 3456
#define XB_SPIN_CAP (1u << 22)
DI unsigned xb_ld(unsigned* p)              { return __hip_atomic_load(p, __ATOMIC_RELAXED, __HIP_MEMORY_SCOPE_AGENT); }
DI unsigned xb_add(unsigned* p, unsigned v) { return __hip_atomic_fetch_add(p, v, __ATOMIC_RELAXED, __HIP_MEMORY_SCOPE_AGENT); }
DI unsigned xb_xcc_id() { return (unsigned)__builtin_amdgcn_s_getreg((3 << 11) | 20) & 0xFu; }
#define XB_SPIN(cond, bar) do { unsigned _sp = 0; while (cond) { __builtin_amdgcn_s_sleep(1); \
    if ((++_sp & 255u) == 0u) { if (xb_ld(&(bar)[XB_TMO])) break; if (_sp > XB_SPIN_CAP) { atomicAdd(&(bar)[XB_TMO], 1u); break; } } } } while (0)
struct XcdBarrier { unsigned* bar; unsigned x; volatile LAS unsigned* st; };
DI XcdBarrier xcd_barrier_post(unsigned* bar, volatile LAS unsigned* st) {
    XcdBarrier b; b.bar = bar; b.x = xb_xcc_id(); b.st = st;
    if (threadIdx.x == 0) (void)xb_add(&bar[XB_XCNT(b.x)], 1u);
    return b;
}
DI void xcd_barrier_complete(unsigned* bar, unsigned x, unsigned& nloc, unsigned& nx) {
    const unsigned G = gridDim.x * gridDim.y * gridDim.z;
    unsigned sum, cnt, mine, sp = 0u;
    for (;;) {
        sum = 0u; cnt = 0u; mine = 0u;
#pragma unroll
        for (unsigned j = 0; j < 16; ++j) { const unsigned c = xb_ld(&bar[XB_XCNT(j)]); sum += c; cnt += (c > 0u) ? 1u : 0u; mine = (j == x) ? c : mine; }
        if (sum == G) break;
        __builtin_amdgcn_s_sleep(1);
        if ((++sp & 255u) == 0u) { if (xb_ld(&bar[XB_TMO])) break; if (sp > XB_SPIN_CAP) { atomicAdd(&bar[XB_TMO], 1u); break; } }
    }
    nloc = mine > 0u ? mine : 1u; nx = cnt > 0u ? cnt : 1u;
}
DI void xcd_barrier(const XcdBarrier& b) {
    asm volatile("s_waitcnt vmcnt(0)" ::: "memory");
    __syncthreads();
    if (threadIdx.x == 0) {
        unsigned* bar = b.bar;
        __builtin_amdgcn_s_waitcnt(0);
        unsigned nloc = b.st[0], nx = b.st[1];
        if (nloc == 0u) { xcd_barrier_complete(bar, b.x, nloc, nx); b.st[0] = nloc; b.st[1] = nx; }
        const unsigned old = xb_add(&bar[XB_XSUB(b.x)], 1u);
        const unsigned gen = old / nloc;
        if (old + 1u == (gen + 1u) * nloc) {
            __builtin_amdgcn_fence(__ATOMIC_RELEASE, "agent");
            asm volatile("s_waitcnt vmcnt(0)" ::: "memory");
            const unsigned og = xb_add(&bar[XB_TOP], 1u);
            const unsigned tg = og / nx;
            if (og + 1u == (tg + 1u) * nx) xb_add(&bar[XB_TOPGEN], 1u);
            else XB_SPIN(xb_ld(&bar[XB_TOPGEN]) == tg, bar);
            __builtin_amdgcn_fence(__ATOMIC_ACQUIRE, "agent");
            xb_add(&bar[XB_XGEN(b.x)], 1u);
            asm volatile("s_waitcnt vmcnt(0)" ::: "memory");
        } else {
            XB_SPIN(xb_ld(&bar[XB_XGEN(b.x)]) == gen, bar);
            __builtin_amdgcn_fence(__ATOMIC_ACQUIRE, "agent");
            asm volatile("s_waitcnt vmcnt(0)" ::: "memory");
        }
    }
    __syncthreads();
}

__global__ void __launch_bounds__(NTHR, 2) mega_fwd(Params p) {
    extern __shared__ __attribute__((aligned(16))) unsigned char lds_raw[];
    LAS unsigned char* lds = (LAS unsigned char*)lds_raw;
    cg::grid_group grid = cg::this_grid();
    unsigned char* ws = p.ws;
    const int lo = p.ph_lo, hi = p.ph_hi;
    const int G = gridDim.x, bid = blockIdx.x;
    if (lo < 0) grid.sync();
    volatile LAS unsigned* xbw = (volatile LAS unsigned*)(lds + LDS_MAIN);
    if (threadIdx.x < 4) xbw[threadIdx.x] = 0u;
    __syncthreads();
    XcdBarrier xbar = xcd_barrier_post((unsigned*)(ws + WS_BAR), xbw);
#define IN(k) (lo <= (k) && (k) < hi)
#define SEAM(k) do { if (IN(k) && IN((k) + 1)) xcd_barrier(xbar); } while (0)

    if (IN(0)) phase0(p, lds);
    SEAM(0);
    if (IN(1)) phase1(p);
    SEAM(1);
    if (IN(2)) {
        pg8::Gemm g{(const bf16_t*)(ws + WS_H), (const bf16_t*)(ws + WS_WIN), NT, PW, D}; pg8::StaticOrder S; S.init(NT, PW, G, bid);
        EpiInProj E{(bf16_t*)(ws + WS_P), (float*)(ws + WS_GD)};
        pg8::gemm_phase<EpiInProj, pg8::StaticOrder, true, true>(lds, g, S, E);
    }
    SEAM(2);
    if (IN(3)) {
        constexpr int N_QK = NT / 64, N_GA = 16 * NPOS;
        constexpr int N_PAIR = N_GA / 2;
        const int n_long = N_PAIR % G;
        if (n_long > 0 && n_long < G) { if (bid >= n_long) for (int it = bid - n_long; it < N_QK; it += G - n_long) qknorm_item(p, it); }
        else for (int it = bid; it < N_QK; it += G) qknorm_item(p, it);
        for (int j = bid; j < N_PAIR; j += G) gla_a_pair(p, lds, j, j + N_PAIR);
    }
    SEAM(3);
    if (IN(4)) {
        const float* ctl = (const float*)(ws + WS_CTL); const float lam = ctl[0], Msh = ctl[1];
        BScan BS;
        if (G == 256) {
            bscan_init(p, BS);
            const int xcd = bid & 7, cu = bid >> 3;
            for (int j = cu; j < 128; j += 32) { const int pair = xcd * 2 + (j >> 6), qb = j & 63; attn_unit<true>(p, lds, pair >> 2, pair & 3, qb, Msh, lam, 0, BS); }
        } else {
            gla_b(p); BS.base = nullptr; BS.dec = nullptr; BS.s0 = BS.s1 = BS.d = 0.f; BS.raw = 0u; BS.step = 0;
            for (int j = bid; j < 1024; j += G) attn_unit<false>(p, lds, j >> 8, (j >> 6) & 3, j & 63, Msh, lam, 0, BS);
        }
    }
    SEAM(4);
    if (IN(5)) {
        for (int j = bid; j < 16 * 128; j += G) gla_c_item(p, lds, j >> 9, (j >> 7) & 3, j & 127);
    }
    SEAM(5);
    if (IN(6)) {
        pg8::Gemm g{(const bf16_t*)(ws + WS_MIX), (const bf16_t*)(ws + WS_WOUT), NLAT, D, D}; pg8::StaticOrder S; S.init(NLAT, D, G, bid);
        EpiOutProj E{p.x, (const float*)(ws + WS_MOD), p.norm2_g, p.out, (bf16_t*)(ws + WS_H), (float*)(ws + WS_ROWSS)};
        pg8::gemm_phase<EpiOutProj, pg8::StaticOrder, true, true>(lds, g, S, E);
    }
    SEAM(6);
    if (IN(7)) {
        pg8::Gemm g{(const bf16_t*)(ws + WS_H), (const bf16_t*)(ws + WS_WF1), NLAT, FH2, D}; pg8::StaticOrder S; S.init(NLAT, FH2, G, bid);
        EpiFfnIn E{(const float*)(ws + WS_ROWSS), (const float*)(ws + WS_BIAS2), (bf16_t*)(ws + WS_P)};
        pg8::gemm_phase<EpiFfnIn, pg8::StaticOrder, true, true>(lds, g, S, E);
    }
    SEAM(7);
    if (IN(8)) {
        pg8::Gemm g{(const bf16_t*)(ws + WS_P), (const bf16_t*)(ws + WS_WF2), NLAT, D, FH}; pg8::StaticOrder S; S.init(NLAT, D, G, bid);
        EpiFfnOut E{(const float*)(ws + WS_MOD), p.out};
        pg8::gemm_phase<EpiFfnOut, pg8::StaticOrder, true, true>(lds, g, S, E);
    }
#undef IN
#undef SEAM
}

#ifndef MK_LAUNCHES
#define MK_LAUNCHES 1
#endif
extern "C" void kernel_launch(void* const* d_in, const int* in_sizes, int n_in, void* d_out, int out_size, void* d_ws, size_t ws_size, hipStream_t stream) {
    static int grid = 0;
    if (grid == 0) {
        if (n_in != 20 || ws_size < WS_END) { fprintf(stderr, "kernel_launch: unexpected n_in %d or ws_size %zu (< %zu)\n", n_in, ws_size, (size_t)WS_END); grid = -1; return; }
        int dev = 0, cus = 0, per_cu = 0;
        hipGetDevice(&dev); hipDeviceGetAttribute(&cus, hipDeviceAttributeMultiprocessorCount, dev);
        if (hipFuncSetAttribute((const void*)mega_fwd, hipFuncAttributeMaxDynamicSharedMemorySize, LDS_BYTES) != hipSuccess) { fprintf(stderr, "kernel_launch: hipFuncSetAttribute failed\n"); grid = -1; return; }
        if (hipOccupancyMaxActiveBlocksPerMultiprocessor(&per_cu, (const void*)mega_fwd, NTHR, LDS_BYTES) != hipSuccess || per_cu < 1) { fprintf(stderr, "kernel_launch: occupancy query failed (%d)\n", per_cu); per_cu = 1; }
        (void)hipGetLastError();
        grid = cus * per_cu;
    }
    if (grid < 0) return;
    if (hipMemsetAsync((char*)d_ws + WS_BAR, 0, XCD_BAR_WORDS * 4, stream) != hipSuccess) { fprintf(stderr, "kernel_launch: memset failed\n"); return; }
    Params p{};
    const float** pp = (const float**)&p;
    for (int i = 0; i < 20; ++i) pp[i] = (const float*)d_in[i];
    p.out = (float*)d_out; p.ws = (unsigned char*)d_ws;
#if MK_LAUNCHES == 1
    p.ph_lo = 0; p.ph_hi = 9;
    void* args[] = {&p};
    hipError_t e = hipLaunchCooperativeKernel((const void*)mega_fwd, dim3(grid), dim3(NTHR), args, LDS_BYTES, stream);
    if (e != hipSuccess) fprintf(stderr, "cooperative launch failed: %s (grid %d)\n", hipGetErrorString(e), grid);
#else
    for (int ph = 0; ph < 9; ++ph) { p.ph_lo = ph; p.ph_hi = ph + 1; hipLaunchKernelGGL(mega_fwd, dim3(grid), dim3(NTHR), LDS_BYTES, stream, p); }
#endif
}
```

```cpp
#include <hip/hip_runtime.h>
#include <hip/hip_cooperative_groups.h>
#include <cstdio>
#include <cstdint>
namespace cg = cooperative_groups;

#define DI __device__ __forceinline__
#define LAS __attribute__((address_space(3)))
typedef unsigned short bf16_t;
typedef short bf16x8 __attribute__((ext_vector_type(8)));
typedef short s16x4 __attribute__((ext_vector_type(4)));
typedef float f32x4 __attribute__((ext_vector_type(4)));
typedef float f32x16 __attribute__((ext_vector_type(16)));
typedef unsigned u32x4 __attribute__((ext_vector_type(4)));
typedef unsigned u32x2 __attribute__((ext_vector_type(2)));
typedef __bf16 bf2_t __attribute__((ext_vector_type(2)));
typedef float f32x2 __attribute__((ext_vector_type(2)));

constexpr int D = 1024, NB = 4, SEQ = 8192, CTXL = 256;
constexpr int NLAT = NB * SEQ, NCTX = NB * CTXL, NT = NLAT + NCTX;
constexpr int PW = 3328;
constexpr int C_GQ = 0, C_GK = 256, C_GV = 512, C_GR = 1024, C_DQ = 1536, C_DK = 2048, C_DV = 2560, C_GD = 3072;
constexpr int FH = 2816, FH2 = 5632;
constexpr int NPOS = 132;
constexpr float EPS = 1e-6f;
constexpr int NTHR = 512;
constexpr int LDS_MAIN = 131072;
constexpr int LDS_BYTES = LDS_MAIN + 256;

constexpr size_t al256(size_t x) { return (x + 255) & ~(size_t)255; }
constexpr size_t WS_CTL = 0;
constexpr size_t WS_BAR = 4096;
constexpr size_t WS_MOD = 4096 + 16384;
constexpr size_t WS_ROPE = al256(WS_MOD + 5 * 6144 * 4);
constexpr size_t WS_ROWSS = al256(WS_ROPE + 128 * 16 * 8);
constexpr size_t WS_BIAS2 = al256(WS_ROWSS + (size_t)NLAT * 4);
constexpr size_t WS_DEC = al256(WS_BIAS2 + (size_t)NB * FH2 * 4);
constexpr size_t WS_GD = al256(WS_DEC + (size_t)32 * NPOS * 64 * 4);
constexpr size_t WS_WIN = al256(WS_GD + (size_t)NT * 32 * 4);
constexpr size_t WS_WOUT = al256(WS_WIN + (size_t)PW * D * 2);
constexpr size_t WS_WF1 = al256(WS_WOUT + (size_t)D * D * 2);
constexpr size_t WS_WF2 = al256(WS_WF1 + (size_t)FH2 * D * 2);
constexpr size_t WS_H = al256(WS_WF2 + (size_t)D * FH * 2);
constexpr size_t WS_MIX = al256(WS_H + (size_t)NT * D * 2);
constexpr size_t WS_DS = al256(WS_MIX + (size_t)NLAT * D * 2);
constexpr size_t WS_P = al256(WS_DS + (size_t)32 * NPOS * 8192 * 2);
constexpr size_t WS_END = al256(WS_P + (size_t)NT * PW * 2);

struct Params {
    const float *x, *c, *ctx, *c_ctx, *w_mod, *b_mod, *norm1_g, *w_in, *gate_up, *gate_bias, *gla_norm_g, *q_norm_g, *k_norm_g, *lam_q, *lam_k, *diff_norm_g,
        *w_out, *norm2_g, *w_ffn_in, *w_ffn_out;
    float* out; unsigned char* ws; int ph_lo, ph_hi;
};

DI unsigned pk_bf16(float lo, float hi) { f32x2 v = {lo, hi}; bf2_t r = __builtin_convertvector(v, bf2_t); return __builtin_bit_cast(unsigned, r); }
DI float bf_lo(unsigned u) { return __uint_as_float(u << 16); }
DI float bf_hi(unsigned u) { return __uint_as_float(u & 0xffff0000u); }
DI float silu_f(float v) { return v * __builtin_amdgcn_rcpf(1.f + __expf(-v)); }
DI float logsig2_16(float z) {
    const float l = __builtin_amdgcn_logf(1.0f + __builtin_amdgcn_exp2f(-fabsf(z)));
    return (fminf(z, 0.f) - l) * (1.0f / 16.0f);
}
DI float logsig_f(float z) { return fminf(z, 0.f) - __logf(1.0f + __expf(-fabsf(z))); }
DI int my_tid() { int t = threadIdx.x; asm volatile("" : "+v"(t)); return t; }
DI float wave_allreduce_sum(float x) {
    x += __builtin_bit_cast(float, __builtin_amdgcn_update_dpp(0, __builtin_bit_cast(int, x), 0xB1, 0xf, 0xf, false));
    x += __builtin_bit_cast(float, __builtin_amdgcn_update_dpp(0, __builtin_bit_cast(int, x), 0x4E, 0xf, 0xf, false));
    x += __builtin_bit_cast(float, __builtin_amdgcn_update_dpp(0, __builtin_bit_cast(int, x), 0x141, 0xf, 0xf, false));
    x += __builtin_bit_cast(float, __builtin_amdgcn_update_dpp(0, __builtin_bit_cast(int, x), 0x140, 0xf, 0xf, false));
    const int xi = __builtin_bit_cast(int, x);
    return (__builtin_bit_cast(float, __builtin_amdgcn_readlane(xi, 0)) + __builtin_bit_cast(float, __builtin_amdgcn_readlane(xi, 16)))
         + (__builtin_bit_cast(float, __builtin_amdgcn_readlane(xi, 32)) + __builtin_bit_cast(float, __builtin_amdgcn_readlane(xi, 48)));
}
DI int crow(int reg, int h) { return (reg & 3) + 8 * (reg >> 2) + 4 * h; }
#define MFMA32(a, b, c) __builtin_amdgcn_mfma_f32_32x32x16_bf16((a), (b), (c), 0, 0, 0)
DI bf16x8 tr_frag(const LAS unsigned char* base, int hi_off) {
    s16x4 lo = __builtin_amdgcn_ds_read_tr16_b64_v4i16((LAS s16x4*)base);
    s16x4 hi = __builtin_amdgcn_ds_read_tr16_b64_v4i16((LAS s16x4*)(base + hi_off));
    return __builtin_shufflevector(lo, hi, 0, 1, 2, 3, 4, 5, 6, 7);
}
DI int srccol(int which, int n) {
    if (which == 0) { if (n < 1536) return n; if (n < 3072) return n + 32; if (n < 3104) return n - 1536; return -1; }
    if (which == 2) { const int pn = n >> 8, bj = (n >> 7) & 1, cc = n & 127; return bj * FH + pn * 128 + cc; }
    return n;
}

namespace pg8 {
constexpr int BM = 256, BK = 64, HALF = 128, HTB = HALF * BK * 2, STAGE_BYTES = 8 * HTB, NXCD = 8, WGM = 8;
DI int lds_byte(int r, int c) { const int st = (r >> 4) * 2 + (c >> 5), rr = r & 15, cc = c & 31, ob = rr * 64 + cc * 2; return st * 1024 + (ob ^ (((ob >> 9) & 1) << 5)); }
DI void stage_rc(int b, int& R, int& C) { const int st = b / 1024, sb = b % 1024, swz = sb ^ (((sb >> 9) & 1) << 5); R = (st >> 1) * 16 + swz / 64; C = (st & 1) * 32 + (swz % 64) / 2; }
DI int perm32(int rho) { const int n = rho >> 4, i = rho & 15; return 8 * (i >> 2) + 4 * n + (i & 3); }
struct Unit { int pm, pn; };
struct Gemm { const bf16_t* A; const bf16_t* Bt; int M, N, K; };
struct StaticOrder {
    int nM, nN, nwg, G, c;
    DI void init(int M, int N, int G_, int c_) { nM = M / BM; nN = N / BM; nwg = nM * nN; G = G_; c = c_; }
    DI bool next(int i, Unit& u) const {
        const long L = (long)i * G + c; if (L >= nwg) return false;
        int wgid = (int)L; { const int q = nwg / NXCD, r = nwg % NXCD, xcd = wgid % NXCD, off = wgid / NXCD; wgid = (xcd < r ? xcd * (q + 1) : r * (q + 1) + (xcd - r) * q) + off; }
        const int nig = WGM * nN, gid = wgid / nig, fm = gid * WGM, gsz = (nM - fm) < WGM ? (nM - fm) : WGM;
        u.pm = fm + ((wgid % nig) % gsz); u.pn = (wgid % nig) / gsz; return true;
    }
    DI void a_ready(const Unit&) const {}
    DI void done(const Unit&) const {}
};
template <class Epi, class Sched, bool ALIGN_EPI = false, bool SP2 = false>
DI void gemm_phase(LAS unsigned char* lds, const Gemm g, const Sched& S, const Epi& E) {
    const int tid = my_tid(), wid = __builtin_amdgcn_readfirstlane(tid >> 6), lane = tid & 63, wr = wid >> 2, wc = wid & 3, fr = lane & 15, fq = lane >> 4;
    const int K = g.K, nt = K / BK;
    unsigned voffA[2], voffB[2];
#pragma unroll
    for (int i = 0; i < 2; ++i) { int R, C; stage_rc(tid * 16 + i * 8192, R, C); const int Rb = Epi::PERM ? ((R & ~31) + perm32(R & 31)) : R;
        voffA[i] = (unsigned)(R * K + C) * 2u; voffB[i] = (unsigned)(Rb * K + C) * 2u; }
    const size_t kstep = (size_t)(BK * 2);
    const size_t hstep = (size_t)HALF * K * 2;
    const size_t tstep = 2 * hstep;
    const unsigned ldsw = (unsigned)wid * 1024u;
    const int aoff = lds_byte(wr * 64 + fr, fq * 8), boff = lds_byte(wc * 32 + fr, fq * 8);
#define PG8_SA(b, h) (((b) * 2 + (h)) * HTB)
#define PG8_SB(b, h) ((4 + (b) * 2 + (h)) * HTB)
#define PG8_STAGE(bufoff, gbase, voff) do { _Pragma("unroll") for (int _i = 0; _i < 2; ++_i) \
        __builtin_amdgcn_global_load_lds((const unsigned*)((const char*)(gbase) + (voff)[_i]), (LAS unsigned*)(lds + (bufoff) + ldsw + _i * 8192), 16, 0, 0); } while (0)
#define PG8_LDA(dst, b, h) do { _Pragma("unroll") for (int m = 0; m < 4; ++m) _Pragma("unroll") for (int k = 0; k < 2; ++k) dst[m][k] = *(const LAS bf16x8*)(lds + PG8_SA(b, h) + aoff + m * 2048 + k * 1024); } while (0)
#define PG8_LDB(dst, b, h) do { _Pragma("unroll") for (int n = 0; n < 2; ++n) _Pragma("unroll") for (int k = 0; k < 2; ++k) dst[n][k] = *(const LAS bf16x8*)(lds + PG8_SB(b, h) + boff + n * 2048 + k * 1024); } while (0)
#define PG8_MMA(ai, bj, At, Bt) do { __builtin_amdgcn_s_setprio(1); _Pragma("unroll") for (int m = 0; m < 4; ++m) _Pragma("unroll") for (int n = 0; n < 2; ++n) _Pragma("unroll") for (int k = 0; k < 2; ++k) \
        acc[ai][bj][m][n] = __builtin_amdgcn_mfma_f32_16x16x32_bf16(Bt[n][k], At[m][k], acc[ai][bj][m][n], 0, 0, 0); __builtin_amdgcn_s_setprio(0); } while (0)
#define PG8_WAIT_V(n) asm volatile("s_waitcnt vmcnt(" #n ")" ::: "memory")
#define PG8_WAIT_L(n) asm volatile("s_waitcnt lgkmcnt(" #n ")" ::: "memory")
#define PG8_BAR __builtin_amdgcn_s_barrier()
#define PG8_SCHED __builtin_amdgcn_sched_barrier(0)
    Unit cur, nxt; int ui = 0;
    if (!S.next(0, cur)) return;
    f32x4 acc[2][2][4][2];
#pragma unroll
    for (int a = 0; a < 2; ++a)
#pragma unroll
        for (int b = 0; b < 2; ++b)
#pragma unroll
            for (int m = 0; m < 4; ++m)
#pragma unroll
                for (int n = 0; n < 2; ++n) acc[a][b][m][n] = (f32x4){0.f, 0.f, 0.f, 0.f};
    bf16x8 At[4][2], B0[2][2], B1[2][2];
    const char* cA = (const char*)g.A + (size_t)cur.pm * tstep; const char* cB = (const char*)g.Bt + (size_t)cur.pn * tstep;
    S.a_ready(cur);
    if constexpr (SP2) {
        PG8_STAGE(PG8_SB(0, 0), cB, voffB); PG8_STAGE(PG8_SB(0, 1), cB + hstep, voffB); PG8_STAGE(PG8_SA(0, 0), cA, voffA); PG8_STAGE(PG8_SA(0, 1), cA + hstep, voffA);
        if (wr == 1) PG8_BAR;
        PG8_WAIT_V(2); PG8_BAR;
        PG8_STAGE(PG8_SB(1, 0), cB + kstep, voffB); PG8_STAGE(PG8_SA(1, 0), cA + kstep, voffA); PG8_STAGE(PG8_SB(1, 1), cB + hstep + kstep, voffB);
        PG8_WAIT_V(6); PG8_BAR;
    } else {
        PG8_STAGE(PG8_SB(0, 0), cB, voffB); PG8_STAGE(PG8_SA(0, 0), cA, voffA); PG8_STAGE(PG8_SB(0, 1), cB + hstep, voffB); PG8_STAGE(PG8_SA(0, 1), cA + hstep, voffA);
        if (wr == 1) PG8_BAR;
        PG8_WAIT_V(4); PG8_BAR;
        PG8_STAGE(PG8_SB(1, 0), cB + kstep, voffB); PG8_STAGE(PG8_SA(1, 0), cA + kstep, voffA); PG8_STAGE(PG8_SB(1, 1), cB + hstep + kstep, voffB);
        PG8_WAIT_V(6); PG8_BAR;
    }
    for (;;) {
        const bool has_next = S.next(ui + 1, nxt);
        const char* nA = has_next ? (const char*)g.A + (size_t)nxt.pm * tstep : cA; const char* nB = has_next ? (const char*)g.Bt + (size_t)nxt.pn * tstep : cB;
        for (int t = 0; t < nt; t += 2) {
            const bool last = (t == nt - 2);
            const char* a1 = cA + (size_t)(t + 1) * kstep;
            const char* a2 = last ? nA : cA + (size_t)(t + 2) * kstep; const char* b2 = last ? nB : cB + (size_t)(t + 2) * kstep;
            const char* a3 = a2 + kstep; const char* b3 = b2 + kstep;
            if (last && has_next) S.a_ready(nxt);
            if constexpr (SP2) {
            PG8_LDB(B0, 0, 0); PG8_LDB(B1, 0, 1); PG8_SCHED; PG8_LDA(At, 0, 0); PG8_STAGE(PG8_SA(1, 1), a1 + hstep, voffA);
            PG8_WAIT_V(8); PG8_WAIT_L(0); PG8_BAR; PG8_MMA(0, 0, At, B0); PG8_MMA(0, 1, At, B1); PG8_BAR; PG8_SCHED;
            PG8_LDA(At, 0, 1); PG8_STAGE(PG8_SB(0, 0), b2, voffB); PG8_STAGE(PG8_SB(0, 1), b2 + hstep, voffB); PG8_STAGE(PG8_SA(0, 0), a2, voffA);
            PG8_WAIT_V(8); PG8_WAIT_L(0); PG8_BAR; PG8_MMA(1, 0, At, B0); PG8_MMA(1, 1, At, B1); PG8_BAR; PG8_SCHED;
            PG8_LDB(B0, 1, 0); PG8_LDB(B1, 1, 1); PG8_SCHED; PG8_LDA(At, 1, 0); PG8_STAGE(PG8_SA(0, 1), a2 + hstep, voffA);
            PG8_WAIT_V(8); PG8_WAIT_L(0); PG8_BAR; PG8_MMA(0, 0, At, B0); PG8_MMA(0, 1, At, B1); PG8_BAR; PG8_SCHED;
            PG8_LDA(At, 1, 1); PG8_STAGE(PG8_SB(1, 0), b3, voffB); PG8_STAGE(PG8_SB(1, 1), b3 + hstep, voffB); PG8_STAGE(PG8_SA(1, 0), a3, voffA);
            PG8_WAIT_V(8); PG8_WAIT_L(0); PG8_BAR; PG8_MMA(1, 0, At, B0); PG8_MMA(1, 1, At, B1); PG8_BAR; PG8_SCHED;
            } else {
            PG8_LDB(B0, 0, 0); PG8_SCHED; PG8_LDA(At, 0, 0); PG8_STAGE(PG8_SA(1, 1), a1 + hstep, voffA);
            PG8_WAIT_L(8); PG8_BAR; PG8_WAIT_L(0); PG8_MMA(0, 0, At, B0); PG8_BAR; PG8_SCHED;
            PG8_LDB(B1, 0, 1); PG8_STAGE(PG8_SB(0, 0), b2, voffB);
            PG8_BAR; PG8_WAIT_L(0); PG8_MMA(0, 1, At, B1); PG8_BAR;
            PG8_LDA(At, 0, 1); PG8_STAGE(PG8_SA(0, 0), a2, voffA);
            PG8_BAR; PG8_WAIT_L(0); PG8_MMA(1, 0, At, B0); PG8_BAR; PG8_SCHED;
            PG8_STAGE(PG8_SB(0, 1), b2 + hstep, voffB);
            PG8_WAIT_V(6); PG8_BAR; PG8_MMA(1, 1, At, B1); PG8_BAR;
            PG8_LDB(B0, 1, 0); PG8_SCHED; PG8_LDA(At, 1, 0); PG8_STAGE(PG8_SA(0, 1), a2 + hstep, voffA);
            PG8_WAIT_L(8); PG8_BAR; PG8_WAIT_L(0); PG8_MMA(0, 0, At, B0); PG8_BAR; PG8_SCHED;
            PG8_LDB(B1, 1, 1); PG8_STAGE(PG8_SB(1, 0), b3, voffB);
            PG8_BAR; PG8_WAIT_L(0); PG8_MMA(0, 1, At, B1); PG8_BAR;
            PG8_LDA(At, 1, 1); PG8_STAGE(PG8_SA(1, 0), a3, voffA);
            PG8_BAR; PG8_WAIT_L(0); PG8_MMA(1, 0, At, B0); PG8_BAR; PG8_SCHED;
            PG8_STAGE(PG8_SB(1, 1), b3 + hstep, voffB);
            PG8_WAIT_V(6); PG8_BAR; PG8_MMA(1, 1, At, B1); PG8_BAR;
            }
        }
        if constexpr (ALIGN_EPI) { if (wr == 0) PG8_BAR; }
        E(acc, cur, wr, wc, fr, fq);
        if (!has_next) break;
#pragma unroll
        for (int a = 0; a < 2; ++a)
#pragma unroll
            for (int b = 0; b < 2; ++b)
#pragma unroll
                for (int m = 0; m < 4; ++m)
#pragma unroll
                    for (int n = 0; n < 2; ++n) acc[a][b][m][n] = (f32x4){0.f, 0.f, 0.f, 0.f};
        cur = nxt; cA = nA; cB = nB; ++ui;
        if constexpr (ALIGN_EPI) { if (wr == 1) PG8_BAR; }
    }
    PG8_WAIT_V(0);
    if constexpr (!ALIGN_EPI) { if (wr == 0) PG8_BAR; }
    PG8_BAR;
#undef PG8_SA
#undef PG8_SB
#undef PG8_STAGE
#undef PG8_LDA
#undef PG8_LDB
#undef PG8_MMA
#undef PG8_WAIT_V
#undef PG8_WAIT_L
#undef PG8_BAR
#undef PG8_SCHED
}
}

typedef f32x4 AccT[2][2][4][2];

struct EpiInProj {
    static constexpr bool PERM = true;
    bf16_t* P; float* GD;
    DI void operator()(const AccT& acc, const pg8::Unit& u, int wr, int wc, int fr, int fq) const {
        const int row0 = u.pm * 256 + wr * 64 + fr;
        if (u.pn < 12) {
            const int col0 = u.pn * 256 + wc * 32 + 8 * fq;
#pragma unroll
            for (int ai = 0; ai < 2; ++ai)
#pragma unroll
                for (int m = 0; m < 4; ++m) { bf16_t* rowp = P + (size_t)(row0 + ai * 128 + m * 16) * PW + col0;
#pragma unroll
                    for (int bj = 0; bj < 2; ++bj) { const f32x4 v0 = acc[ai][bj][m][0], v1 = acc[ai][bj][m][1];
                        u32x4 w; w.x = pk_bf16(v0[0], v0[1]); w.y = pk_bf16(v0[2], v0[3]); w.z = pk_bf16(v1[0], v1[1]); w.w = pk_bf16(v1[2], v1[3]);
                        *(u32x4*)(rowp + bj * 128) = w; } }
        } else if (wc == 0) {
#pragma unroll
            for (int ai = 0; ai < 2; ++ai)
#pragma unroll
                for (int m = 0; m < 4; ++m) { float* rowp = GD + (size_t)(row0 + ai * 128 + m * 16) * 32 + 8 * fq;
                    *(f32x4*)(rowp) = acc[ai][0][m][0]; *(f32x4*)(rowp + 4) = acc[ai][0][m][1]; }
        }
    }
};
struct EpiOutProj {
    static constexpr bool PERM = true;
    const float* x; const float* mod; const float* n2g; float* out; bf16_t* H2; float* rowss;
    DI void operator()(const AccT& acc, const pg8::Unit& u, int wr, int wc, int fr, int fq) const {
        const int row0 = u.pm * 256 + wr * 64 + fr; const int b = (u.pm * 256) >> 13;
        const float* mb = mod + b * 6144;
#pragma unroll
        for (int ai = 0; ai < 2; ++ai)
#pragma unroll
            for (int m = 0; m < 4; ++m) { const int row = row0 + ai * 128 + m * 16; float ss = 0.f;
#pragma unroll
                for (int bj = 0; bj < 2; ++bj) { const int c0 = u.pn * 256 + bj * 128 + wc * 32 + 8 * fq; const size_t off = (size_t)row * D + c0;
                    unsigned w[4];
#pragma unroll
                    for (int n = 0; n < 2; ++n) { const f32x4 xv = *(const f32x4*)(x + off + 4 * n); const f32x4 gt = *(const f32x4*)(mb + 2048 + c0 + 4 * n);
                        const f32x4 sc = *(const f32x4*)(mb + 4096 + c0 + 4 * n); const f32x4 gg = *(const f32x4*)(n2g + c0 + 4 * n);
                        const f32x4 x1 = xv + gt * acc[ai][bj][m][n]; *(f32x4*)(out + off + 4 * n) = x1;
                        ss += (x1[0] * x1[0] + x1[1] * x1[1]) + (x1[2] * x1[2] + x1[3] * x1[3]);
                        const f32x4 hv = x1 * gg * (sc + 1.0f); w[2 * n] = pk_bf16(hv[0], hv[1]); w[2 * n + 1] = pk_bf16(hv[2], hv[3]); }
                    u32x4 ww; ww.x = w[0]; ww.y = w[1]; ww.z = w[2]; ww.w = w[3]; *(u32x4*)(H2 + off) = ww; }
                ss += __shfl_xor(ss, 16); ss += __shfl_xor(ss, 32);
                if (fq == 0) atomicAdd(rowss + row, ss); }
    }
};
struct EpiFfnIn {
    static constexpr bool PERM = true;
    const float* rowss; const float* bias2; bf16_t* ACT;
    DI void operator()(const AccT& acc, const pg8::Unit& u, int wr, int wc, int fr, int fq) const {
        const int row0 = u.pm * 256 + wr * 64 + fr; const int b = (u.pm * 256) >> 13;
        const float* bb = bias2 + b * FH2 + u.pn * 256 + wc * 32 + 8 * fq;
        f32x4 bg[2], bu[2];
#pragma unroll
        for (int n = 0; n < 2; ++n) { bg[n] = *(const f32x4*)(bb + 4 * n); bu[n] = *(const f32x4*)(bb + 128 + 4 * n); }
#pragma unroll
        for (int ai = 0; ai < 2; ++ai)
#pragma unroll
            for (int m = 0; m < 4; ++m) { const int row = row0 + ai * 128 + m * 16; const float rs = rsqrtf(rowss[row] * (1.0f / 1024.0f) + EPS);
                unsigned w[4];
#pragma unroll
                for (int n = 0; n < 2; ++n) { const f32x4 gt = acc[ai][0][m][n] * rs + bg[n]; const f32x4 up = acc[ai][1][m][n] * rs + bu[n];
                    const f32x4 t = gt * (-1.4426950409f);
                    f32x4 dn_ = {__builtin_amdgcn_exp2f(t[0]), __builtin_amdgcn_exp2f(t[1]), __builtin_amdgcn_exp2f(t[2]), __builtin_amdgcn_exp2f(t[3])};
                    dn_ = dn_ + 1.0f;
                    const f32x4 rc = {__builtin_amdgcn_rcpf(dn_[0]), __builtin_amdgcn_rcpf(dn_[1]), __builtin_amdgcn_rcpf(dn_[2]), __builtin_amdgcn_rcpf(dn_[3])};
                    const f32x4 o = (gt * up) * rc;
                    w[2 * n] = pk_bf16(o[0], o[1]); w[2 * n + 1] = pk_bf16(o[2], o[3]); }
                u32x4 ww; ww.x = w[0]; ww.y = w[1]; ww.z = w[2]; ww.w = w[3];
                *(u32x4*)(ACT + (size_t)row * FH + u.pn * 128 + wc * 32 + 8 * fq) = ww; }
    }
};
struct EpiFfnOut {
    static constexpr bool PERM = true;
    const float* mod; float* out;
    DI void operator()(const AccT& acc, const pg8::Unit& u, int wr, int wc, int fr, int fq) const {
        const int row0 = u.pm * 256 + wr * 64 + fr; const int b = (u.pm * 256) >> 13;
        const float* mb = mod + b * 6144 + 5120;
#pragma unroll
        for (int ai = 0; ai < 2; ++ai)
#pragma unroll
            for (int m = 0; m < 4; ++m) { const int row = row0 + ai * 128 + m * 16;
#pragma unroll
                for (int bj = 0; bj < 2; ++bj) { const int c0 = u.pn * 256 + bj * 128 + wc * 32 + 8 * fq; const size_t off = (size_t)row * D + c0;
#pragma unroll
                    for (int n = 0; n < 2; ++n) { const f32x4 xv = *(const f32x4*)(out + off + 4 * n); const f32x4 gt = *(const f32x4*)(mb + c0 + 4 * n);
                        *(f32x4*)(out + off + 4 * n) = xv + gt * acc[ai][bj][m][n]; } } }
    }
};

DI void adaln_item(const Params& p, int item, LAS unsigned char* lds, float* mod) {
    const int tid = my_tid();
    LAS float* scond = (LAS float*)lds;
    LAS float* red = scond + 5 * 1024;
    for (int i = tid; i < 5 * 1024; i += NTHR) { const int b = i >> 10, k = i & 1023; const float v = b < 4 ? p.c[b * 1024 + k] : p.c_ctx[k]; scond[i] = silu_f(v); }
    __syncthreads();
    const int cl = tid & 31, kg = tid >> 5, col = item * 32 + cl;
    float a0 = 0.f, a1 = 0.f, a2 = 0.f, a3 = 0.f, a4 = 0.f;
    for (int k8 = 0; k8 < 64; k8 += 8) { float wv[8];
#pragma unroll
        for (int u = 0; u < 8; ++u) wv[u] = p.w_mod[(size_t)(kg * 64 + k8 + u) * 6144 + col];
#pragma unroll
        for (int u = 0; u < 8; ++u) { const int k = kg * 64 + k8 + u; const float w = wv[u];
            a0 += scond[k] * w; a1 += scond[1024 + k] * w; a2 += scond[2048 + k] * w; a3 += scond[3072 + k] * w; a4 += scond[4096 + k] * w; } }
    LAS float* rp = red + (kg * 32 + cl) * 5; rp[0] = a0; rp[1] = a1; rp[2] = a2; rp[3] = a3; rp[4] = a4;
    __syncthreads();
    if (tid < 160) { const int b = tid >> 5, c2 = tid & 31; float s_ = p.b_mod[item * 32 + c2];
#pragma unroll
        for (int g = 0; g < 16; ++g) s_ += red[(g * 32 + c2) * 5 + b];
        mod[b * 6144 + item * 32 + c2] = s_; }
    __syncthreads();
}
DI void transpose_item(const float* src, int ldn, bf16_t* dst, int K, int k0, int n0, int which, LAS unsigned char* lds) {
    const int tid = my_tid(); LAS float* t = (LAS float*)lds;
#pragma unroll
    for (int i = 0; i < 2; ++i) { const int kk = (tid >> 4) + 32 * i, nn = (tid & 15) * 4, n = n0 + nn; const int sc = srccol(which, n);
        f32x4 v = sc >= 0 ? *(const f32x4*)(src + (size_t)(k0 + kk) * ldn + sc) : (f32x4){0.f, 0.f, 0.f, 0.f}; if (which == 0 && n < 256) v = v * 0.125f;
        *(LAS f32x4*)(t + kk * 68 + nn) = v; }
    __syncthreads();
    { const int nn = tid >> 3, kc = tid & 7; u32x4 w;
      w.x = pk_bf16(t[(kc * 8 + 0) * 68 + nn], t[(kc * 8 + 1) * 68 + nn]); w.y = pk_bf16(t[(kc * 8 + 2) * 68 + nn], t[(kc * 8 + 3) * 68 + nn]);
      w.z = pk_bf16(t[(kc * 8 + 4) * 68 + nn], t[(kc * 8 + 5) * 68 + nn]); w.w = pk_bf16(t[(kc * 8 + 6) * 68 + nn], t[(kc * 8 + 7) * 68 + nn]);
      *(u32x4*)(dst + (size_t)(n0 + nn) * K + k0 + kc * 8) = w; }
    __syncthreads();
}
DI void phase0(const Params& p, LAS unsigned char* lds) {
    unsigned char* ws = p.ws; const int tid = my_tid();
    float* mod = (float*)(ws + WS_MOD);
    constexpr int N_ADA = 192, T_IN = 16 * 52, T_OUT = 16 * 16, T_F1 = 16 * 88, T_F2 = 44 * 16, N_ZERO = 27;
    constexpr int O1 = N_ADA, O2 = O1 + T_IN, O3 = O2 + T_OUT, O4 = O3 + T_F1, O5 = O4 + T_F2, O6 = O5 + 1, TOT = O6 + N_ZERO;
    for (int it = blockIdx.x; it < TOT; it += gridDim.x) {
        if (it < O1) adaln_item(p, it, lds, mod);
        else if (it < O2) { const int j = it - O1; transpose_item(p.w_in, 3104, (bf16_t*)(ws + WS_WIN), D, (j & 15) * 64, (j >> 4) * 64, 0, lds); }
        else if (it < O3) { const int j = it - O2; transpose_item(p.w_out, D, (bf16_t*)(ws + WS_WOUT), D, (j & 15) * 64, (j >> 4) * 64, 1, lds); }
        else if (it < O4) { const int j = it - O3; transpose_item(p.w_ffn_in, FH2, (bf16_t*)(ws + WS_WF1), D, (j & 15) * 64, (j >> 4) * 64, 2, lds); }
        else if (it < O5) { const int j = it - O4; transpose_item(p.w_ffn_out, D, (bf16_t*)(ws + WS_WF2), FH, (j % 44) * 64, (j / 44) * 64, 3, lds); }
        else if (it < O6) {
            f32x2* tab = (f32x2*)(ws + WS_ROPE);
            for (int idx = tid; idx < 2048; idx += NTHR) { const int pos = idx >> 4, f = idx & 15; const float inv = powf(10000.0f, -(float)f / 16.0f); const float ang = (float)pos * inv;
                tab[idx] = (f32x2){cosf(ang), sinf(ang)}; }
            if (tid == 0) { float s0 = 0.f, s1 = 0.f, mq = 0.f, mk = 0.f;
                for (int i = 0; i < 64; ++i) { s0 += p.lam_q[i] * p.lam_k[i]; s1 += p.lam_q[64 + i] * p.lam_k[64 + i]; mq = fmaxf(mq, fabsf(p.q_norm_g[i])); mk = fmaxf(mk, fabsf(p.k_norm_g[i])); }
                float* ctl = (float*)(ws + WS_CTL); ctl[0] = expf(s0) - expf(s1) + 0.2f;
                ctl[1] = 8.0f * 1.4426950409f * mq * mk * 1.02f + 0.25f; }
        } else { const int j = it - O6; const int idx = j * 2048 + tid * 4;
            if (idx < NLAT) *(f32x4*)((float*)(ws + WS_ROWSS) + idx) = (f32x4){0.f, 0.f, 0.f, 0.f};
            else if (idx - NLAT < NB * FH2) *(f32x4*)((float*)(ws + WS_BIAS2) + (idx - NLAT)) = (f32x4){0.f, 0.f, 0.f, 0.f}; }
    }
}

DI void phase1(const Params& p) {
    unsigned char* ws = p.ws; const int tid = my_tid(), lane = tid & 63, wave = tid >> 6;
    const float* mod = (const float*)(ws + WS_MOD); bf16_t* H = (bf16_t*)(ws + WS_H); float* bias2 = (float*)(ws + WS_BIAS2);
    constexpr int N_ROW = NT / 16, N_B2 = 22 * 16;
    for (int it = blockIdx.x; it < N_ROW + N_B2; it += gridDim.x) {
        if (it < N_ROW) {
            const float* src[2]; const float* mb[2]; f32x4 v[2][4]; float ss[2];
#pragma unroll
            for (int u = 0; u < 2; ++u) { const int row = it * 16 + wave * 2 + u;
                if (row < NLAT) { src[u] = p.x + (size_t)row * D; mb[u] = mod + (row >> 13) * 6144; } else { src[u] = p.ctx + (size_t)(row - NLAT) * D; mb[u] = mod + 4 * 6144; }
#pragma unroll
                for (int i = 0; i < 4; ++i) v[u][i] = *(const f32x4*)(src[u] + 4 * lane + 256 * i); }
#pragma unroll
            for (int u = 0; u < 2; ++u) { ss[u] = 0.f;
#pragma unroll
                for (int i = 0; i < 4; ++i) ss[u] += (v[u][i][0] * v[u][i][0] + v[u][i][1] * v[u][i][1]) + (v[u][i][2] * v[u][i][2] + v[u][i][3] * v[u][i][3]);
                ss[u] = wave_allreduce_sum(ss[u]); }
#pragma unroll
            for (int u = 0; u < 2; ++u) { const int row = it * 16 + wave * 2 + u; const float rs = rsqrtf(ss[u] * (1.0f / 1024.0f) + EPS);
#pragma unroll
                for (int i = 0; i < 4; ++i) { const int c = 4 * lane + 256 * i; const f32x4 g = *(const f32x4*)(p.norm1_g + c), sh = *(const f32x4*)(mb[u] + c), sc = *(const f32x4*)(mb[u] + 1024 + c);
                    const f32x4 h = v[u][i] * rs * g * (sc + 1.0f) + sh; u32x2 w; w.x = pk_bf16(h[0], h[1]); w.y = pk_bf16(h[2], h[3]); *(u32x2*)(H + (size_t)row * D + c) = w; } }
        } else {
            const int idx = it - N_ROW, nb = idx % 22, kc = idx / 22; const int nn = tid & 255, half = tid >> 8; const int n = nb * 256 + nn, sc = srccol(2, n);
            float a0 = 0.f, a1 = 0.f, a2 = 0.f, a3 = 0.f;
            for (int kk = 0; kk < 32; ++kk) { const int k = kc * 64 + half * 32 + kk; const float w = p.w_ffn_in[(size_t)k * FH2 + sc];
                a0 += mod[3072 + k] * w; a1 += mod[6144 + 3072 + k] * w; a2 += mod[2 * 6144 + 3072 + k] * w; a3 += mod[3 * 6144 + 3072 + k] * w; }
            atomicAdd(bias2 + n, a0); atomicAdd(bias2 + FH2 + n, a1); atomicAdd(bias2 + 2 * FH2 + n, a2); atomicAdd(bias2 + 3 * FH2 + n, a3);
        }
    }
}

#define DPPF(x, ctrl) __builtin_bit_cast(float, __builtin_amdgcn_update_dpp(0, __builtin_bit_cast(int, (x)), (ctrl), 0xf, 0xf, false))
DI void qknorm_item(const Params& p, int item) {
    unsigned char* ws = p.ws; const int tid = my_tid(); bf16_t* P = (bf16_t*)(ws + WS_P); const f32x2* tab = (const f32x2*)(ws + WS_ROPE);
    const int sub = tid & 63, j = sub & 7;
    const float* gsrc = p.k_norm_g + 8 * j;
    float g[8];
#pragma unroll
    for (int e = 0; e < 8; ++e) g[e] = gsrc[e];
    const int axis = j >> 2, half = (j >> 1) & 1, f0 = 8 * (j & 1);
    u32x4 raws[8];
#pragma unroll
    for (int u = 0; u < 8; ++u) raws[u] = *(const u32x4*)(P + (size_t)(item * 64 + u * 8 + (tid >> 6)) * PW + C_DK + sub * 8);
#pragma unroll
    for (int u = 0; u < 8; ++u) {
        const int row = item * 64 + u * 8 + (tid >> 6);
        bf16_t* ptr = P + (size_t)row * PW + C_DK + sub * 8;
        const u32x4 raw = raws[u];
        float v[8]; v[0] = bf_lo(raw.x); v[1] = bf_hi(raw.x); v[2] = bf_lo(raw.y); v[3] = bf_hi(raw.y); v[4] = bf_lo(raw.z); v[5] = bf_hi(raw.z); v[6] = bf_lo(raw.w); v[7] = bf_hi(raw.w);
        float ss = 0.f;
#pragma unroll
        for (int e = 0; e < 8; ++e) ss += v[e] * v[e];
        ss += DPPF(ss, 0xB1); ss += DPPF(ss, 0x4E); ss += DPPF(ss, 0x141);
        const float rs = rsqrtf(ss * (1.0f / 64.0f) + EPS);
#pragma unroll
        for (int e = 0; e < 8; ++e) v[e] = v[e] * rs * g[e];
        if (row < NLAT) {
            const int t = row & (SEQ - 1); const int pos = axis ? (t & 63) : (t >> 6);
#pragma unroll
            for (int e = 0; e < 8; ++e) { const float o = DPPF(v[e], 0x4E); const f32x2 cs = tab[pos * 16 + f0 + e];
                v[e] = half ? (v[e] * cs.x + o * cs.y) : (v[e] * cs.x - o * cs.y); }
        }
        u32x4 w; w.x = pk_bf16(v[0], v[1]); w.y = pk_bf16(v[2], v[3]); w.z = pk_bf16(v[4], v[5]); w.w = pk_bf16(v[6], v[7]);
        *(u32x4*)ptr = w;
    }
}


#define DPP_ADD(x, ctrl) ((x) + __builtin_bit_cast(float, __builtin_amdgcn_update_dpp(0, __builtin_bit_cast(int, (x)), (ctrl), 0xf, 0xf, false)))
DI float scan_prefix64(float x, int lane) {
    x = DPP_ADD(x, 0x111); x = DPP_ADD(x, 0x112); x = DPP_ADD(x, 0x114); x = DPP_ADD(x, 0x118);
    x += __builtin_bit_cast(float, __builtin_amdgcn_update_dpp(0, __builtin_bit_cast(int, x), 0x142, 0xa, 0xf, false));
    x += __builtin_bit_cast(float, __builtin_amdgcn_update_dpp(0, __builtin_bit_cast(int, x), 0x143, 0xc, 0xf, false));
    return x;
}
DI float scan_suffix64(float x, int lane) {
    const float pre = scan_prefix64(x, lane);
    const float tot = __builtin_bit_cast(float, __builtin_amdgcn_readlane(__builtin_bit_cast(int, pre), 63));
    return (tot - pre) + x;
}
#define GLA_GATES(dir, g)                                                                                                           \
    do {                                                                                                                           \
        f32x2 z2_[4];                                                                                                               \
        _Pragma("unroll") for (int c2 = 0; c2 < 4; ++c2) z2_[c2] = *(const f32x2*)(p.gate_bias + (dir) * 256 + h * 64 + ch0 + 2 * c2) * 1.4426950409f; \
        _Pragma("unroll") for (int rr = 0; rr < 16; ++rr) {                                                                         \
            const f32x4 ga_ = *(const LAS f32x4*)(GU + ((dir) * 16 + rr) * 64 + ch0), gb_ = *(const LAS f32x4*)(GU + ((dir) * 16 + rr) * 64 + ch0 + 4); \
            const f32x2 dv_ = {dn[(dir) * 16 + rr], dn[(dir) * 16 + rr]};                                                           \
            z2_[0] += dv_ * (f32x2){ga_[0], ga_[1]}; z2_[1] += dv_ * (f32x2){ga_[2], ga_[3]};                                       \
            z2_[2] += dv_ * (f32x2){gb_[0], gb_[1]}; z2_[3] += dv_ * (f32x2){gb_[2], gb_[3]};                                       \
        }                                                                                                                          \
        _Pragma("unroll") for (int c = 0; c < 8; ++c) g[c] = logsig2_16(z2_[c >> 1][c & 1]);                                        \
        _Pragma("unroll") for (int c = 0; c < 8; ++c) g[c] = (dir) == 0 ? scan_prefix64(g[c], lane) : scan_suffix64(g[c], lane);             \
    } while (0)

DI void gla_a_pair(const Params& p, LAS unsigned char* lds0, int jA, int jB) {
    unsigned char* ws = p.ws; const int tid = my_tid(), lane = tid & 63, wave = __builtin_amdgcn_readfirstlane(tid >> 6);
    const int half = wave >> 2, w4 = wave & 3, tidh = tid & 255;
    const int j = half ? jB : jA; const int b = j / (4 * NPOS), h = (j / NPOS) & 3, cc = j % NPOS;
    LAS unsigned char* lds = lds0 + half * 53248;
    const bf16_t* P = (const bf16_t*)(ws + WS_P); const float* GDp = (const float*)(ws + WS_GD); bf16_t* DS = (bf16_t*)(ws + WS_DS); float* DEC = (float*)(ws + WS_DEC);
    const int row0 = cc < 4 ? NLAT + b * CTXL + cc * 64 : b * SEQ + (cc - 4) * 64;
    LAS float* GU = (LAS float*)lds;
    LAS unsigned char* KI0 = lds + 8192;
    LAS unsigned char* KI1 = lds + 8192 + 12288;
    LAS unsigned char* VI = lds + 8192 + 24576;
#pragma unroll
    for (int i = 0; i < 8; ++i) { const int idx = tidh + 256 * i; const int dir = idx >> 10, rr = (idx >> 6) & 15, c = idx & 63; GU[idx] = p.gate_up[(dir * 16 + rr) * 256 + h * 64 + c] * 1.4426950409f; }
#pragma unroll
    for (int i = 0; i < 4; ++i) { const int id = tidh + 256 * i, row = id >> 4, c16 = id & 15;
        *(LAS u32x4*)(VI + row * 320 + c16 * 16) = *(const u32x4*)(P + (size_t)(row0 + row) * PW + C_GV + h * 128 + c16 * 8); }
    float dn[32];
#pragma unroll
    for (int i = 0; i < 8; ++i) { const f32x4 t = *(const f32x4*)(GDp + (size_t)(row0 + lane) * 32 + 4 * i); dn[4 * i] = t[0]; dn[4 * i + 1] = t[1]; dn[4 * i + 2] = t[2]; dn[4 * i + 3] = t[3]; }
    u32x4 kraw2[2], qraw2[2];
#pragma unroll
    for (int cb = 0; cb < 2; ++cb) { kraw2[cb] = *(const u32x4*)(P + (size_t)(row0 + lane) * PW + C_GK + h * 64 + 16 * w4 + 8 * cb);
        qraw2[cb] = *(const u32x4*)(P + (size_t)(row0 + lane) * PW + (cc >= 4 ? C_GQ : C_GK) + h * 64 + 16 * w4 + 8 * cb); }
    __syncthreads();
    const int seq0 = (b * 4 + h) * 2;
    const int pos0 = cc, pos1 = cc < 4 ? 3 - cc : 135 - cc;
#pragma unroll
    for (int cb = 0; cb < 2; ++cb) {
        const int ch0 = 16 * w4 + 8 * cb;
        const u32x4 kraw = kraw2[cb], qraw = qraw2[cb];
        float kf[8]; kf[0] = bf_lo(kraw.x); kf[1] = bf_hi(kraw.x); kf[2] = bf_lo(kraw.y); kf[3] = bf_hi(kraw.y); kf[4] = bf_lo(kraw.z); kf[5] = bf_hi(kraw.z); kf[6] = bf_lo(kraw.w); kf[7] = bf_hi(kraw.w);
        float qf8[8]; qf8[0] = bf_lo(qraw.x); qf8[1] = bf_hi(qraw.x); qf8[2] = bf_lo(qraw.y); qf8[3] = bf_hi(qraw.y); qf8[4] = bf_lo(qraw.z); qf8[5] = bf_hi(qraw.z); qf8[6] = bf_lo(qraw.w); qf8[7] = bf_hi(qraw.w);
        bf16_t* QKT = (bf16_t*)(ws + WS_H) + ((size_t)((b * 4 + h) * 128 + (cc - 4)) * 4) * 4096 + lane * 64 + ch0;
#pragma unroll
        for (int dir = 0; dir < 2; ++dir) {
            float g[8]; GLA_GATES(dir, g);
            float kh[8];
            float eg[8], ieg[8], et[8];
#pragma unroll
            for (int c = 0; c < 8; ++c) { const float tot = __builtin_bit_cast(float, __builtin_amdgcn_readlane(__builtin_bit_cast(int, g[c]), dir == 0 ? 63 : 0)); et[c] = __builtin_amdgcn_exp2f(tot); eg[c] = __builtin_amdgcn_exp2f(g[c]); ieg[c] = __builtin_amdgcn_exp2f(fminf(-g[c], 86.0f)); kh[c] = (kf[c] * ieg[c]) * et[c]; }
            if (lane == 0) { float* dp = DEC + ((size_t)(seq0 + dir) * NPOS + (dir == 0 ? pos0 : pos1)) * 64 + ch0;
                *(f32x4*)dp = (f32x4){et[0], et[1], et[2], et[3]}; *(f32x4*)(dp + 4) = (f32x4){et[4], et[5], et[6], et[7]}; }
            u32x4 w; w.x = pk_bf16(kh[0], kh[1]); w.y = pk_bf16(kh[2], kh[3]); w.z = pk_bf16(kh[4], kh[5]); w.w = pk_bf16(kh[6], kh[7]);
            *(LAS u32x4*)((dir == 0 ? KI0 : KI1) + lane * 192 + ch0 * 2) = w;
            if (cc >= 4) {
                float qt[8], kt[8];
#pragma unroll
                for (int c = 0; c < 8; ++c) { qt[c] = qf8[c] * eg[c]; kt[c] = kf[c] * ieg[c]; }
                u32x4 wq, wk; wq.x = pk_bf16(qt[0], qt[1]); wq.y = pk_bf16(qt[2], qt[3]); wq.z = pk_bf16(qt[4], qt[5]); wq.w = pk_bf16(qt[6], qt[7]);
                wk.x = pk_bf16(kt[0], kt[1]); wk.y = pk_bf16(kt[2], kt[3]); wk.z = pk_bf16(kt[4], kt[5]); wk.w = pk_bf16(kt[6], kt[7]);
                *(u32x4*)(QKT + (dir * 2 + 0) * 4096) = wq; *(u32x4*)(QKT + (dir * 2 + 1) * 4096) = wk;
            }
        }
    }
    __syncthreads();
    const int r = lane & 31, hh = lane >> 5, q = (lane & 15) >> 2, pc = lane & 3, blk = (lane >> 4) & 1;
    const int dkt = w4 & 1, dv2 = (w4 >> 1) * 2;
    f32x16 af0 = {}, af1 = {}, ab0 = {}, ab1 = {};
#pragma unroll
    for (int s_ = 0; s_ < 4; ++s_) {
        const bf16x8 b0 = tr_frag(VI + (16 * s_ + 8 * hh + q) * 320 + dv2 * 64 + 32 * blk + 8 * pc, 4 * 320);
        const bf16x8 b1 = tr_frag(VI + (16 * s_ + 8 * hh + q) * 320 + (dv2 + 1) * 64 + 32 * blk + 8 * pc, 4 * 320);
        const bf16x8 a0 = tr_frag(KI0 + (16 * s_ + 8 * hh + q) * 192 + dkt * 64 + 32 * blk + 8 * pc, 4 * 192);
        const bf16x8 a1 = tr_frag(KI1 + (16 * s_ + 8 * hh + q) * 192 + dkt * 64 + 32 * blk + 8 * pc, 4 * 192);
        af0 = MFMA32(a0, b0, af0); af1 = MFMA32(a0, b1, af1); ab0 = MFMA32(a1, b0, ab0); ab1 = MFMA32(a1, b1, ab1);
    }
    bf16_t* o0 = DS + ((size_t)(seq0 + 0) * NPOS + pos0) * 8192 + (dkt * 32) * 128 + dv2 * 32 + r;
    bf16_t* o1 = DS + ((size_t)(seq0 + 1) * NPOS + pos1) * 8192 + (dkt * 32) * 128 + dv2 * 32 + r;
#pragma unroll
    for (int i = 0; i < 16; ++i) { const int dk = crow(i, hh);
        const unsigned wf = pk_bf16(af0[i], af1[i]), wb = pk_bf16(ab0[i], ab1[i]);
        o0[dk * 128] = (bf16_t)(wf & 0xffffu); o0[dk * 128 + 32] = (bf16_t)(wf >> 16);
        o1[dk * 128] = (bf16_t)(wb & 0xffffu); o1[dk * 128 + 32] = (bf16_t)(wb >> 16); }
    __syncthreads();
}

DI void gla_b(const Params& p) {
    unsigned char* ws = p.ws; unsigned* DS = (unsigned*)(ws + WS_DS); const float* DEC = (const float*)(ws + WS_DEC);
    const int nthr = gridDim.x * NTHR;
    for (int e = blockIdx.x * NTHR + my_tid(); e < 32 * 64 * 64; e += nthr) {
        const int seq = e >> 12, dk = (e >> 6) & 63, dvp = e & 63;
        unsigned* base = DS + (size_t)seq * NPOS * 4096 + dk * 64 + dvp; const float* dec = DEC + (size_t)seq * NPOS * 64 + dk;
        float s0 = 0.f, s1 = 0.f;
        for (int pp = 0; pp < NPOS; pp += 12) {
            unsigned raw[12]; float d[12];
#pragma unroll
            for (int u = 0; u < 12; ++u) { raw[u] = base[(size_t)(pp + u) * 4096]; d[u] = dec[(pp + u) * 64]; }
#pragma unroll
            for (int u = 0; u < 12; ++u) { base[(size_t)(pp + u) * 4096] = pk_bf16(s0, s1); s0 = d[u] * s0 + bf_lo(raw[u]); s1 = d[u] * s1 + bf_hi(raw[u]); }
        }
    }
}

DI void gla_c_item(const Params& p, LAS unsigned char* lds, int b, int h, int c) {
    unsigned char* ws = p.ws; const int tid = my_tid(), lane = tid & 63, wave = __builtin_amdgcn_readfirstlane(tid >> 6);
    const bf16_t* P = (const bf16_t*)(ws + WS_P); const float* GDp = (const float*)(ws + WS_GD); const bf16_t* DS = (const bf16_t*)(ws + WS_DS); bf16_t* MIX = (bf16_t*)(ws + WS_MIX);
    const int row0 = b * SEQ + c * 64; const int ch0 = 8 * wave;
    LAS float* GU = (LAS float*)lds;
    LAS unsigned char* QI0 = lds + 8192;
    LAS unsigned char* KI0 = lds + 8192 + 9216;
    LAS unsigned char* QI1 = lds + 8192 + 2 * 9216;
    LAS unsigned char* KI1 = lds + 8192 + 3 * 9216;
    LAS unsigned char* VI = lds + 45056;
    LAS unsigned char* SI0 = lds + 65536;
    LAS unsigned char* SI1 = lds + 86016;
    LAS float* RED = (LAS float*)(lds + 106496);
    const int seq0 = (b * 4 + h) * 2; const int pos0 = c + 4, pos1 = 131 - c;
    const bf16_t* s0p = DS + ((size_t)(seq0 + 0) * NPOS + pos0) * 8192; const bf16_t* s1p = DS + ((size_t)(seq0 + 1) * NPOS + pos1) * 8192;
    const bf16_t* QKT = (const bf16_t*)(ws + WS_H) + ((size_t)((b * 4 + h) * 128 + c) * 4) * 4096;
#pragma unroll
    for (int i = 0; i < 2; ++i) { const int id = tid + NTHR * i, row = id >> 4, c16 = id & 15;
        *(LAS u32x4*)(VI + row * 320 + c16 * 16) = *(const u32x4*)(P + (size_t)(row0 + row) * PW + C_GV + h * 128 + c16 * 8);
        *(LAS u32x4*)(SI0 + row * 320 + c16 * 16) = *(const u32x4*)(s0p + row * 128 + c16 * 8);
        *(LAS u32x4*)(SI1 + row * 320 + c16 * 16) = *(const u32x4*)(s1p + row * 128 + c16 * 8); }
    { const int row = tid >> 3, c8 = tid & 7;
      *(LAS u32x4*)(QI0 + row * 144 + c8 * 16) = *(const u32x4*)(QKT + 0 * 4096 + row * 64 + c8 * 8);
      *(LAS u32x4*)(KI0 + row * 144 + c8 * 16) = *(const u32x4*)(QKT + 1 * 4096 + row * 64 + c8 * 8);
      *(LAS u32x4*)(QI1 + row * 144 + c8 * 16) = *(const u32x4*)(QKT + 2 * 4096 + row * 64 + c8 * 8);
      *(LAS u32x4*)(KI1 + row * 144 + c8 * 16) = *(const u32x4*)(QKT + 3 * 4096 + row * 64 + c8 * 8); }
    const int r = lane & 31, hh = lane >> 5, q = (lane & 15) >> 2, pc = lane & 3, blk = (lane >> 4) & 1;
    const int it = wave & 1, dvt = wave >> 1;
    const size_t rowg = (size_t)(row0 + 32 * it + r);
    u32x2 rgate[4];
#pragma unroll
    for (int gi = 0; gi < 4; ++gi) rgate[gi] = *(const u32x2*)(P + rowg * PW + C_GR + h * 128 + 32 * dvt + 8 * gi + 4 * hh);
    __syncthreads();
    f32x16 O = {};
#pragma unroll
    for (int dir = 0; dir < 2; ++dir) {
        const LAS unsigned char* QI = dir == 0 ? QI0 : QI1; const LAS unsigned char* KI = dir == 0 ? KI0 : KI1; const LAS unsigned char* SI = dir == 0 ? SI0 : SI1;
        bf16x8 qfr[4];
#pragma unroll
        for (int ks = 0; ks < 4; ++ks) qfr[ks] = *(const LAS bf16x8*)(QI + (32 * it + r) * 144 + (16 * ks + 8 * hh) * 2);
#pragma unroll
        for (int jt = 0; jt < 2; ++jt) {
            if (dir == 0 ? (jt > it) : (jt < it)) continue;
            f32x16 X = {};
#pragma unroll
            for (int ks = 0; ks < 4; ++ks) { const bf16x8 a = *(const LAS bf16x8*)(KI + (32 * jt + r) * 144 + (16 * ks + 8 * hh) * 2); X = MFMA32(a, qfr[ks], X); }
            if (jt == it) {
#pragma unroll
                for (int i = 0; i < 16; ++i) { const int jl = crow(i, hh); const bool keep = dir == 0 ? (jl <= r) : (jl >= r); X[i] = keep ? X[i] : 0.f; }
            }
            u32x4 w0, w1; w0.x = pk_bf16(X[0], X[1]); w0.y = pk_bf16(X[2], X[3]); w0.z = pk_bf16(X[4], X[5]); w0.w = pk_bf16(X[6], X[7]);
            w1.x = pk_bf16(X[8], X[9]); w1.y = pk_bf16(X[10], X[11]); w1.z = pk_bf16(X[12], X[13]); w1.w = pk_bf16(X[14], X[15]);
            const bf16x8 pb0 = __builtin_bit_cast(bf16x8, w0), pb1 = __builtin_bit_cast(bf16x8, w1);
            const bf16x8 v0 = tr_frag(VI + (32 * jt + 4 * hh + q) * 320 + dvt * 64 + 32 * blk + 8 * pc, 8 * 320);
            const bf16x8 v1 = tr_frag(VI + (32 * jt + 16 + 4 * hh + q) * 320 + dvt * 64 + 32 * blk + 8 * pc, 8 * 320);
            O = MFMA32(v0, pb0, O); O = MFMA32(v1, pb1, O);
        }
#pragma unroll
        for (int ks = 0; ks < 4; ++ks) { const bf16x8 a3 = tr_frag(SI + (16 * ks + 8 * hh + q) * 320 + dvt * 64 + 32 * blk + 8 * pc, 4 * 320); O = MFMA32(a3, qfr[ks], O); }
    }
    float ss = 0.f;
#pragma unroll
    for (int i = 0; i < 16; ++i) ss += O[i] * O[i];
    ss += __shfl_xor(ss, 32);
    if (lane < 32) RED[(it * 4 + dvt) * 32 + r] = ss;
    __syncthreads();
    const float tot = (RED[(it * 4 + 0) * 32 + r] + RED[(it * 4 + 1) * 32 + r]) + (RED[(it * 4 + 2) * 32 + r] + RED[(it * 4 + 3) * 32 + r]);
    const float rs = rsqrtf(tot * (1.0f / 128.0f) + EPS);
#pragma unroll
    for (int gi = 0; gi < 4; ++gi) { const int dv0 = 32 * dvt + 8 * gi + 4 * hh;
        const u32x2 rr = rgate[gi]; const f32x4 gn = *(const f32x4*)(p.gla_norm_g + dv0);
        const float o0 = O[4 * gi] * rs * gn[0] * silu_f(bf_lo(rr.x)), o1 = O[4 * gi + 1] * rs * gn[1] * silu_f(bf_hi(rr.x));
        const float o2 = O[4 * gi + 2] * rs * gn[2] * silu_f(bf_lo(rr.y)), o3 = O[4 * gi + 3] * rs * gn[3] * silu_f(bf_hi(rr.y));
        u32x2 w; w.x = pk_bf16(o0, o1); w.y = pk_bf16(o2, o3); *(u32x2*)(MIX + rowg * D + h * 128 + dv0) = w; }
    __syncthreads();
}

constexpr int ATT_KB = 64 * 272, ATT_VB = 64 * 320, ATT_BUF = ATT_KB + ATT_VB;
DI void att_stage(f32x16& Snew, const f32x16& Sold, const LAS unsigned char* Kp, const LAS unsigned char* Vp, const bf16x8 (&qf)[4], const float negM, f32x16 (&acc)[4], float& lsum) {
    float pe[16];
#pragma unroll
    for (int i = 0; i < 16; ++i) Snew[i] = negM;
    { const bf16x8 a = *(const LAS bf16x8*)(Kp); Snew = MFMA32(a, qf[0], Snew); }
#pragma unroll
    for (int i = 0; i < 4; ++i) pe[i] = __builtin_amdgcn_exp2f(Sold[i]);
    { const bf16x8 a = *(const LAS bf16x8*)(Kp + 32); Snew = MFMA32(a, qf[1], Snew); }
#pragma unroll
    for (int i = 4; i < 8; ++i) pe[i] = __builtin_amdgcn_exp2f(Sold[i]);
    { const bf16x8 a = *(const LAS bf16x8*)(Kp + 64); Snew = MFMA32(a, qf[2], Snew); }
#pragma unroll
    for (int i = 8; i < 12; ++i) pe[i] = __builtin_amdgcn_exp2f(Sold[i]);
    { const bf16x8 a = *(const LAS bf16x8*)(Kp + 96); Snew = MFMA32(a, qf[3], Snew); }
#pragma unroll
    for (int i = 12; i < 16; ++i) pe[i] = __builtin_amdgcn_exp2f(Sold[i]);
    lsum += ((pe[0] + pe[1]) + (pe[2] + pe[3])) + ((pe[4] + pe[5]) + (pe[6] + pe[7])) + ((pe[8] + pe[9]) + (pe[10] + pe[11])) + ((pe[12] + pe[13]) + (pe[14] + pe[15]));
    u32x4 w0, w1; w0.x = pk_bf16(pe[0], pe[1]); w0.y = pk_bf16(pe[2], pe[3]); w0.z = pk_bf16(pe[4], pe[5]); w0.w = pk_bf16(pe[6], pe[7]);
    w1.x = pk_bf16(pe[8], pe[9]); w1.y = pk_bf16(pe[10], pe[11]); w1.z = pk_bf16(pe[12], pe[13]); w1.w = pk_bf16(pe[14], pe[15]);
    const bf16x8 pb0 = __builtin_bit_cast(bf16x8, w0), pb1 = __builtin_bit_cast(bf16x8, w1);
#pragma unroll
    for (int t = 0; t < 4; ++t) { const bf16x8 v0 = tr_frag(Vp + t * 64, 8 * 320); acc[t] = MFMA32(v0, pb0, acc[t]); }
#pragma unroll
    for (int t = 0; t < 4; ++t) { const bf16x8 v1 = tr_frag(Vp + 16 * 320 + t * 64, 8 * 320); acc[t] = MFMA32(v1, pb1, acc[t]); }
}
struct BScan { unsigned* base; const float* dec; float s0, s1; unsigned raw; float d; int step; };
DI void bscan_init(const Params& p, BScan& B) {
    unsigned char* ws = p.ws; const int e = blockIdx.x * NTHR + my_tid();
    const int seq = e >> 12, dk = (e >> 6) & 63, dvp = e & 63;
    B.base = (unsigned*)(ws + WS_DS) + (size_t)seq * NPOS * 4096 + dk * 64 + dvp; B.dec = (const float*)(ws + WS_DEC) + (size_t)seq * NPOS * 64 + dk;
    B.s0 = 0.f; B.s1 = 0.f; B.raw = 0u; B.d = 0.f; B.step = 0;
}
DI void bscan_top(BScan& B) {
    if ((B.step & 3) == 0) { const int pp = B.step >> 2; B.raw = B.base[(size_t)pp * 4096]; B.d = B.dec[pp * 64]; B.base[(size_t)pp * 4096] = pk_bf16(B.s0, B.s1); }
}
DI void bscan_bottom(BScan& B) {
    if ((B.step & 3) == 0) { B.s0 = B.d * B.s0 + bf_lo(B.raw); B.s1 = B.d * B.s1 + bf_hi(B.raw); }
    ++B.step;
}
template <bool FUSEB>
DI void attn_unit(const Params& p, LAS unsigned char* lds, int b, int h, int qblk, float Mshift, float lam, int trot, BScan& BS) {
    unsigned char* ws = p.ws; const int tid = my_tid(), lane = tid & 63, wave = __builtin_amdgcn_readfirstlane(tid >> 6);
    const bf16_t* P = (const bf16_t*)(ws + WS_P); bf16_t* MIX = (bf16_t*)(ws + WS_MIX);
    const int r = lane & 31, hh = lane >> 5, q = (lane & 15) >> 2, pc = lane & 3, blk = (lane >> 4) & 1;
    const int comp = wave >> 2, wq = wave & 3;
    const size_t qrow = (size_t)b * SEQ + qblk * 128 + wq * 32 + r;
    bf16x8 qf[4];
    {
        const f32x2* tab = (const f32x2*)(ws + WS_ROPE);
        u32x4 qraw[4];
#pragma unroll
        for (int ks = 0; ks < 4; ++ks) qraw[ks] = *(const u32x4*)(P + qrow * PW + C_DQ + h * 128 + comp * 64 + ks * 16 + hh * 8);
        float y[4][8]; float ss = 0.f;
#pragma unroll
        for (int ks = 0; ks < 4; ++ks) { y[ks][0] = bf_lo(qraw[ks].x); y[ks][1] = bf_hi(qraw[ks].x); y[ks][2] = bf_lo(qraw[ks].y); y[ks][3] = bf_hi(qraw[ks].y);
            y[ks][4] = bf_lo(qraw[ks].z); y[ks][5] = bf_hi(qraw[ks].z); y[ks][6] = bf_lo(qraw[ks].w); y[ks][7] = bf_hi(qraw[ks].w);
#pragma unroll
            for (int j = 0; j < 8; ++j) ss += y[ks][j] * y[ks][j]; }
        ss += __shfl_xor(ss, 32);
        const float rs = rsqrtf(ss * (1.0f / 64.0f) + EPS) * (0.125f * 1.4426950409f);
#pragma unroll
        for (int ks = 0; ks < 4; ++ks)
#pragma unroll
            for (int j = 0; j < 8; ++j) y[ks][j] *= rs * p.q_norm_g[ks * 16 + hh * 8 + j];
        const int tq = qblk * 128 + wq * 32 + r;
#pragma unroll
        for (int ax = 0; ax < 2; ++ax) { const int pos = ax ? (tq & 63) : (tq >> 6);
#pragma unroll
            for (int j = 0; j < 8; ++j) { const f32x2 cs = tab[pos * 16 + hh * 8 + j]; const float x1 = y[2 * ax][j], x2 = y[2 * ax + 1][j];
                y[2 * ax][j] = x1 * cs.x - x2 * cs.y; y[2 * ax + 1][j] = x2 * cs.x + x1 * cs.y; } }
#pragma unroll
        for (int ks = 0; ks < 4; ++ks) { u32x4 w; w.x = pk_bf16(y[ks][0], y[ks][1]); w.y = pk_bf16(y[ks][2], y[ks][3]); w.z = pk_bf16(y[ks][4], y[ks][5]); w.w = pk_bf16(y[ks][6], y[ks][7]);
            qf[ks] = __builtin_bit_cast(bf16x8, w); }
    }
    f32x16 acc[4];
#pragma unroll
    for (int t = 0; t < 4; ++t)
#pragma unroll
        for (int i = 0; i < 16; ++i) acc[t][i] = 0.f;
    const float negM = -Mshift;
    float lsum = 0.f;
    const int ldr = tid >> 4, ldc = tid & 15;
    const int koff = (r) * 272 + comp * 128 + hh * 16;
    const int voff = ATT_KB + (4 * hh + q) * 320 + 32 * blk + 8 * pc;
    u32x4 kreg[2], vreg[2];
#define ATT_GROW(kt, row) ((kt) < 4 ? (size_t)(NLAT + b * CTXL + (kt) * 64 + (row)) : (size_t)(b * SEQ + ((kt) - 4) * 64 + (row)))
#define ATT_LOAD(kr, vr, kt0) do { int kt_ = (kt0) + trot; kt_ = kt_ >= NPOS ? kt_ - NPOS : kt_; _Pragma("unroll") for (int i_ = 0; i_ < 2; ++i_) { const bf16_t* g_ = P + ATT_GROW(kt_, ldr + 32 * i_) * PW + h * 128 + ldc * 8; \
        kr[i_] = *(const u32x4*)(g_ + C_DK); vr[i_] = *(const u32x4*)(g_ + C_DV); } } while (0)
#define ATT_STORE(kr, vr, bufp) do { _Pragma("unroll") for (int i_ = 0; i_ < 2; ++i_) { *(LAS u32x4*)((bufp) + (ldr + 32 * i_) * 272 + ldc * 16) = kr[i_]; \
        *(LAS u32x4*)((bufp) + ATT_KB + (ldr + 32 * i_) * 320 + ldc * 16) = vr[i_]; } } while (0)
    for (int i = tid; i < ATT_VB / 16; i += NTHR) *(LAS u32x4*)(lds + 2 * ATT_BUF + ATT_KB + i * 16) = (u32x4){0u, 0u, 0u, 0u};
    ATT_LOAD(kreg, vreg, 0); ATT_STORE(kreg, vreg, lds);
    __syncthreads();
    f32x16 S0, S1;
#pragma unroll
    for (int i = 0; i < 16; ++i) { S1[i] = -1.0e30f; S0[i] = 0.f; }
    int cur = 0, prv = 2, nxt = 1;
    for (int kt = 0; kt < NPOS; ++kt) {
        const LAS unsigned char* Bc = lds + cur * ATT_BUF; const LAS unsigned char* Bp = lds + prv * ATT_BUF;
        if (kt + 1 < NPOS) ATT_LOAD(kreg, vreg, kt + 1);
        if (FUSEB) bscan_top(BS);
        __builtin_amdgcn_sched_barrier(0);
        att_stage(S0, S1, Bc + koff, Bp + voff + 32 * 320, qf, negM, acc, lsum);
        att_stage(S1, S0, Bc + koff + 32 * 272, Bc + voff, qf, negM, acc, lsum);
        __builtin_amdgcn_sched_barrier(0);
        if (kt + 1 < NPOS) ATT_STORE(kreg, vreg, lds + nxt * ATT_BUF);
        if (FUSEB) bscan_bottom(BS);
        __syncthreads();
        { const int t_ = prv; prv = cur; cur = nxt; nxt = t_; }
    }
#undef ATT_GROW
#undef ATT_LOAD
#undef ATT_STORE
    {
        const LAS unsigned char* Vp = lds + prv * ATT_BUF + voff + 32 * 320;
        float pe[16];
#pragma unroll
        for (int i = 0; i < 16; ++i) { pe[i] = __builtin_amdgcn_exp2f(S1[i]); lsum += pe[i]; }
        u32x4 w0, w1; w0.x = pk_bf16(pe[0], pe[1]); w0.y = pk_bf16(pe[2], pe[3]); w0.z = pk_bf16(pe[4], pe[5]); w0.w = pk_bf16(pe[6], pe[7]);
        w1.x = pk_bf16(pe[8], pe[9]); w1.y = pk_bf16(pe[10], pe[11]); w1.z = pk_bf16(pe[12], pe[13]); w1.w = pk_bf16(pe[14], pe[15]);
        const bf16x8 pb0 = __builtin_bit_cast(bf16x8, w0), pb1 = __builtin_bit_cast(bf16x8, w1);
#pragma unroll
        for (int t = 0; t < 4; ++t) { const bf16x8 v0 = tr_frag(Vp + t * 64, 8 * 320); const bf16x8 v1 = tr_frag(Vp + 16 * 320 + t * 64, 8 * 320);
            acc[t] = MFMA32(v0, pb0, acc[t]); acc[t] = MFMA32(v1, pb1, acc[t]); }
    }
    __syncthreads();
    const float l = lsum + __shfl_xor(lsum, 32);
    const float sc = (comp ? lam : 1.0f) / l;
#pragma unroll
    for (int t = 0; t < 4; ++t)
#pragma unroll
        for (int i = 0; i < 16; ++i) acc[t][i] *= sc;
    LAS float* X = (LAS float*)lds + wq * 4096;
    if (comp == 1) {
#pragma unroll
        for (int t = 0; t < 4; ++t)
#pragma unroll
            for (int i = 0; i < 16; ++i) X[(t * 16 + i) * 64 + lane] = acc[t][i];
    }
    __syncthreads();
    if (comp == 0) {
        float ss = 0.f;
#pragma unroll
        for (int t = 0; t < 4; ++t)
#pragma unroll
            for (int i = 0; i < 16; ++i) { acc[t][i] -= X[(t * 16 + i) * 64 + lane]; ss += acc[t][i] * acc[t][i]; }
        ss += __shfl_xor(ss, 32);
        const float rs = rsqrtf(ss * (1.0f / 128.0f) + EPS) * 0.8f;
#pragma unroll
        for (int t = 0; t < 4; ++t)
#pragma unroll
            for (int gi = 0; gi < 4; ++gi) { const int dv0 = 32 * t + 8 * gi + 4 * hh; const f32x4 gn = *(const f32x4*)(p.diff_norm_g + dv0);
                u32x2 w; w.x = pk_bf16(acc[t][4 * gi] * rs * gn[0], acc[t][4 * gi + 1] * rs * gn[1]); w.y = pk_bf16(acc[t][4 * gi + 2] * rs * gn[2], acc[t][4 * gi + 3] * rs * gn[3]);
                *(u32x2*)(MIX + qrow * D + 512 + h * 128 + dv0) = w; }
    }
    __syncthreads();
}

#define XB_TMO      128
#define XB_XCNT(j)  (256  + 64 * (j))
#define XB_XSUB(j)  (1280 + 64 * (j))
#define XB_XGEN(j)  (2304 + 64 * (j))
#define XB_TOP      3328
#define XB_TOPGEN   3392
#define XCD_BAR_WORDS 3456
#define XB_SPIN_CAP (1u << 22)
DI unsigned xb_ld(unsigned* p)              { return __hip_atomic_load(p, __ATOMIC_RELAXED, __HIP_MEMORY_SCOPE_AGENT); }
DI unsigned xb_add(unsigned* p, unsigned v) { return __hip_atomic_fetch_add(p, v, __ATOMIC_RELAXED, __HIP_MEMORY_SCOPE_AGENT); }
DI unsigned xb_xcc_id() { return (unsigned)__builtin_amdgcn_s_getreg((3 << 11) | 20) & 0xFu; }
#define XB_SPIN(cond, bar) do { unsigned _sp = 0; while (cond) { __builtin_amdgcn_s_sleep(1); \
    if ((++_sp & 255u) == 0u) { if (xb_ld(&(bar)[XB_TMO])) break; if (_sp > XB_SPIN_CAP) { atomicAdd(&(bar)[XB_TMO], 1u); break; } } } } while (0)
struct XcdBarrier { unsigned* bar; unsigned x; volatile LAS unsigned* st; };
DI XcdBarrier xcd_barrier_post(unsigned* bar, volatile LAS unsigned* st) {
    XcdBarrier b; b.bar = bar; b.x = xb_xcc_id(); b.st = st;
    if (threadIdx.x == 0) (void)xb_add(&bar[XB_XCNT(b.x)], 1u);
    return b;
}
DI void xcd_barrier_complete(unsigned* bar, unsigned x, unsigned& nloc, unsigned& nx) {
    const unsigned G = gridDim.x * gridDim.y * gridDim.z;
    unsigned sum, cnt, mine, sp = 0u;
    for (;;) {
        sum = 0u; cnt = 0u; mine = 0u;
#pragma unroll
        for (unsigned j = 0; j < 16; ++j) { const unsigned c = xb_ld(&bar[XB_XCNT(j)]); sum += c; cnt += (c > 0u) ? 1u : 0u; mine = (j == x) ? c : mine; }
        if (sum == G) break;
        __builtin_amdgcn_s_sleep(1);
        if ((++sp & 255u) == 0u) { if (xb_ld(&bar[XB_TMO])) break; if (sp > XB_SPIN_CAP) { atomicAdd(&bar[XB_TMO], 1u); break; } }
    }
    nloc = mine > 0u ? mine : 1u; nx = cnt > 0u ? cnt : 1u;
}
DI void xcd_barrier(const XcdBarrier& b) {
    asm volatile("s_waitcnt vmcnt(0)" ::: "memory");
    __syncthreads();
    if (threadIdx.x == 0) {
        unsigned* bar = b.bar;
        __builtin_amdgcn_s_waitcnt(0);
        unsigned nloc = b.st[0], nx = b.st[1];
        if (nloc == 0u) { xcd_barrier_complete(bar, b.x, nloc, nx); b.st[0] = nloc; b.st[1] = nx; }
        const unsigned old = xb_add(&bar[XB_XSUB(b.x)], 1u);
        const unsigned gen = old / nloc;
        if (old + 1u == (gen + 1u) * nloc) {
            __builtin_amdgcn_fence(__ATOMIC_RELEASE, "agent");
            asm volatile("s_waitcnt vmcnt(0)" ::: "memory");
            const unsigned og = xb_add(&bar[XB_TOP], 1u);
            const unsigned tg = og / nx;
            if (og + 1u == (tg + 1u) * nx) xb_add(&bar[XB_TOPGEN], 1u);
            else XB_SPIN(xb_ld(&bar[XB_TOPGEN]) == tg, bar);
            __builtin_amdgcn_fence(__ATOMIC_ACQUIRE, "agent");
            xb_add(&bar[XB_XGEN(b.x)], 1u);
            asm volatile("s_waitcnt vmcnt(0)" ::: "memory");
        } else {
            XB_SPIN(xb_ld(&bar[XB_XGEN(b.x)]) == gen, bar);
            __builtin_amdgcn_fence(__ATOMIC_ACQUIRE, "agent");
            asm volatile("s_waitcnt vmcnt(0)" ::: "memory");
        }
    }
    __syncthreads();
}

__global__ void __launch_bounds__(NTHR, 2) mega_fwd(Params p) {
    extern __shared__ __attribute__((aligned(16))) unsigned char lds_raw[];
    LAS unsigned char* lds = (LAS unsigned char*)lds_raw;
    cg::grid_group grid = cg::this_grid();
    unsigned char* ws = p.ws;
    const int lo = p.ph_lo, hi = p.ph_hi;
    const int G = gridDim.x, bid = blockIdx.x;
    if (lo < 0) grid.sync();
    volatile LAS unsigned* xbw = (volatile LAS unsigned*)(lds + LDS_MAIN);
    if (threadIdx.x < 4) xbw[threadIdx.x] = 0u;
    __syncthreads();
    XcdBarrier xbar = xcd_barrier_post((unsigned*)(ws + WS_BAR), xbw);
#define IN(k) (lo <= (k) && (k) < hi)
#define SEAM(k) do { if (IN(k) && IN((k) + 1)) xcd_barrier(xbar); } while (0)

    if (IN(0)) phase0(p, lds);
    SEAM(0);
    if (IN(1)) phase1(p);
    SEAM(1);
    if (IN(2)) {
        pg8::Gemm g{(const bf16_t*)(ws + WS_H), (const bf16_t*)(ws + WS_WIN), NT, PW, D}; pg8::StaticOrder S; S.init(NT, PW, G, bid);
        EpiInProj E{(bf16_t*)(ws + WS_P), (float*)(ws + WS_GD)};
        pg8::gemm_phase<EpiInProj, pg8::StaticOrder, true, true>(lds, g, S, E);
    }
    SEAM(2);
    if (IN(3)) {
        constexpr int N_QK = NT / 64, N_GA = 16 * NPOS;
        constexpr int N_PAIR = N_GA / 2;
        const int n_long = N_PAIR % G;
        if (n_long > 0 && n_long < G) { if (bid >= n_long) for (int it = bid - n_long; it < N_QK; it += G - n_long) qknorm_item(p, it); }
        else for (int it = bid; it < N_QK; it += G) qknorm_item(p, it);
        for (int j = bid; j < N_PAIR; j += G) gla_a_pair(p, lds, j, j + N_PAIR);
    }
    SEAM(3);
    if (IN(4)) {
        const float* ctl = (const float*)(ws + WS_CTL); const float lam = ctl[0], Msh = ctl[1];
        BScan BS;
        if (G == 256) {
            bscan_init(p, BS);
            const int xcd = bid & 7, cu = bid >> 3;
            for (int j = cu; j < 128; j += 32) { const int pair = xcd * 2 + (j >> 6), qb = j & 63; attn_unit<true>(p, lds, pair >> 2, pair & 3, qb, Msh, lam, 0, BS); }
        } else {
            gla_b(p); BS.base = nullptr; BS.dec = nullptr; BS.s0 = BS.s1 = BS.d = 0.f; BS.raw = 0u; BS.step = 0;
            for (int j = bid; j < 1024; j += G) attn_unit<false>(p, lds, j >> 8, (j >> 6) & 3, j & 63, Msh, lam, 0, BS);
        }
    }
    SEAM(4);
    if (IN(5)) {
        for (int j = bid; j < 16 * 128; j += G) gla_c_item(p, lds, j >> 9, (j >> 7) & 3, j & 127);
    }
    SEAM(5);
    if (IN(6)) {
        pg8::Gemm g{(const bf16_t*)(ws + WS_MIX), (const bf16_t*)(ws + WS_WOUT), NLAT, D, D}; pg8::StaticOrder S; S.init(NLAT, D, G, bid);
        EpiOutProj E{p.x, (const float*)(ws + WS_MOD), p.norm2_g, p.out, (bf16_t*)(ws + WS_H), (float*)(ws + WS_ROWSS)};
        pg8::gemm_phase<EpiOutProj, pg8::StaticOrder, true, true>(lds, g, S, E);
    }
    SEAM(6);
    if (IN(7)) {
        pg8::Gemm g{(const bf16_t*)(ws + WS_H), (const bf16_t*)(ws + WS_WF1), NLAT, FH2, D}; pg8::StaticOrder S; S.init(NLAT, FH2, G, bid);
        EpiFfnIn E{(const float*)(ws + WS_ROWSS), (const float*)(ws + WS_BIAS2), (bf16_t*)(ws + WS_P)};
        pg8::gemm_phase<EpiFfnIn, pg8::StaticOrder, true, true>(lds, g, S, E);
    }
    SEAM(7);
    if (IN(8)) {
        pg8::Gemm g{(const bf16_t*)(ws + WS_P), (const bf16_t*)(ws + WS_WF2), NLAT, D, FH}; pg8::StaticOrder S; S.init(NLAT, D, G, bid);
        EpiFfnOut E{(const float*)(ws + WS_MOD), p.out};
        pg8::gemm_phase<EpiFfnOut, pg8::StaticOrder, true, true>(lds, g, S, E);
    }
#undef IN
#undef SEAM
}

#ifndef MK_LAUNCHES
#define MK_LAUNCHES 1
#endif
extern "C" void kernel_launch(void* const* d_in, const int* in_sizes, int n_in, void* d_out, int out_size, void* d_ws, size_t ws_size, hipStream_t stream) {
    static int grid = 0;
    if (grid == 0) {
        if (n_in != 20 || ws_size < WS_END) { fprintf(stderr, "kernel_launch: unexpected n_in %d or ws_size %zu (< %zu)\n", n_in, ws_size, (size_t)WS_END); grid = -1; return; }
        int dev = 0, cus = 0, per_cu = 0;
        hipGetDevice(&dev); hipDeviceGetAttribute(&cus, hipDeviceAttributeMultiprocessorCount, dev);
        if (hipFuncSetAttribute((const void*)mega_fwd, hipFuncAttributeMaxDynamicSharedMemorySize, LDS_BYTES) != hipSuccess) { fprintf(stderr, "kernel_launch: hipFuncSetAttribute failed\n"); grid = -1; return; }
        if (hipOccupancyMaxActiveBlocksPerMultiprocessor(&per_cu, (const void*)mega_fwd, NTHR, LDS_BYTES) != hipSuccess || per_cu < 1) { fprintf(stderr, "kernel_launch: occupancy query failed (%d)\n", per_cu); per_cu = 1; }
        (void)hipGetLastError();
        grid = cus * per_cu;
    }
    if (grid < 0) return;
    if (hipMemsetAsync((char*)d_ws + WS_BAR, 0, XCD_BAR_WORDS * 4, stream) != hipSuccess) { fprintf(stderr, "kernel_launch: memset failed\n"); return; }
    Params p{};
    const float** pp = (const float**)&p;
    for (int i = 0; i < 20; ++i) pp[i] = (const float*)d_in[i];
    p.out = (float*)d_out; p.ws = (unsigned char*)d_ws;
#if MK_LAUNCHES == 1
    p.ph_lo = 0; p.ph_hi = 9;
    void* args[] = {&p};
    hipError_t e = hipLaunchCooperativeKernel((const void*)mega_fwd, dim3(grid), dim3(NTHR), args, LDS_BYTES, stream);
    if (e != hipSuccess) fprintf(stderr, "cooperative launch failed: %s (grid %d)\n", hipGetErrorString(e), grid);
#else
    for (int ph = 0; ph < 9; ++ph) { p.ph_lo = ph; p.ph_hi = ph + 1; hipLaunchKernelGGL(mega_fwd, dim3(grid), dim3(NTHR), LDS_BYTES, stream, p); }
#endif
}
```

```cpp
#include <hip/hip_runtime.h>
#include <hip/hip_cooperative_groups.h>
#include <cstdio>
#include <cstdint>
namespace cg = cooperative_groups;

#define DI __device__ __forceinline__
#define LAS __attribute__((address_space(3)))
typedef unsigned short bf16_t;
typedef short bf16x8 __attribute__((ext_vector_type(8)));
typedef short s16x4 __attribute__((ext_vector_type(4)));
typedef float f32x4 __attribute__((ext_vector_type(4)));
typedef float f32x16 __attribute__((ext_vector_type(16)));
typedef unsigned u32x4 __attribute__((ext_vector_type(4)));
typedef unsigned u32x2 __attribute__((ext_vector_type(2)));
typedef __bf16 bf2_t __attribute__((ext_vector_type(2)));
typedef float f32x2 __attribute__((ext_vector_type(2)));

constexpr int D = 1024, NB = 4, SEQ = 8192, CTXL = 256;
constexpr int NLAT = NB * SEQ, NCTX = NB * CTXL, NT = NLAT + NCTX;
constexpr int PW = 3328;
constexpr int C_GQ = 0, C_GK = 256, C_GV = 512, C_GR = 1024, C_DQ = 1536, C_DK = 2048, C_DV = 2560, C_GD = 3072;
constexpr int FH = 2816, FH2 = 5632;
constexpr int NPOS = 132;
constexpr float EPS = 1e-6f;
constexpr int NTHR = 512;
constexpr int LDS_MAIN = 131072;
constexpr int LDS_BYTES = LDS_MAIN + 256;

constexpr size_t al256(size_t x) { return (x + 255) & ~(size_t)255; }
constexpr size_t WS_CTL = 0;
constexpr size_t WS_BAR = 4096;
constexpr size_t WS_MOD = 4096 + 16384;
constexpr size_t WS_ROPE = al256(WS_MOD + 5 * 6144 * 4);
constexpr size_t WS_ROWSS = al256(WS_ROPE + 128 * 16 * 8);
constexpr size_t WS_BIAS2 = al256(WS_ROWSS + (size_t)NLAT * 4);
constexpr size_t WS_DEC = al256(WS_BIAS2 + (size_t)NB * FH2 * 4);
constexpr size_t WS_GD = al256(WS_DEC + (size_t)32 * NPOS * 64 * 4);
constexpr size_t WS_WIN = al256(WS_GD + (size_t)NT * 32 * 4);
constexpr size_t WS_WOUT = al256(WS_WIN + (size_t)PW * D * 2);
constexpr size_t WS_WF1 = al256(WS_WOUT + (size_t)D * D * 2);
constexpr size_t WS_WF2 = al256(WS_WF1 + (size_t)FH2 * D * 2);
constexpr size_t WS_H = al256(WS_WF2 + (size_t)D * FH * 2);
constexpr size_t WS_MIX = al256(WS_H + (size_t)NT * D * 2);
constexpr size_t WS_DS = al256(WS_MIX + (size_t)NLAT * D * 2);
constexpr size_t WS_P = al256(WS_DS + (size_t)32 * NPOS * 8192 * 2);
constexpr size_t WS_END = al256(WS_P + (size_t)NT * PW * 2);

struct Params {
    const float *x, *c, *ctx, *c_ctx, *w_mod, *b_mod, *norm1_g, *w_in, *gate_up, *gate_bias, *gla_norm_g, *q_norm_g, *k_norm_g, *lam_q, *lam_k, *diff_norm_g,
        *w_out, *norm2_g, *w_ffn_in, *w_ffn_out;
    float* out; unsigned char* ws; int ph_lo, ph_hi;
};

DI unsigned pk_bf16(float lo, float hi) { f32x2 v = {lo, hi}; bf2_t r = __builtin_convertvector(v, bf2_t); return __builtin_bit_cast(unsigned, r); }
DI float bf_lo(unsigned u) { return __uint_as_float(u << 16); }
DI float bf_hi(unsigned u) { return __uint_as_float(u & 0xffff0000u); }
DI float silu_f(float v) { return v * __builtin_amdgcn_rcpf(1.f + __expf(-v)); }
DI float logsig2_16(float z) {
    const float l = __builtin_amdgcn_logf(1.0f + __builtin_amdgcn_exp2f(-fabsf(z)));
    return (fminf(z, 0.f) - l) * (1.0f / 16.0f);
}
DI float logsig_f(float z) { return fminf(z, 0.f) - __logf(1.0f + __expf(-fabsf(z))); }
DI int my_tid() { int t = threadIdx.x; asm volatile("" : "+v"(t)); return t; }
DI float wave_allreduce_sum(float x) {
    x += __builtin_bit_cast(float, __builtin_amdgcn_update_dpp(0, __builtin_bit_cast(int, x), 0xB1, 0xf, 0xf, false));
    x += __builtin_bit_cast(float, __builtin_amdgcn_update_dpp(0, __builtin_bit_cast(int, x), 0x4E, 0xf, 0xf, false));
    x += __builtin_bit_cast(float, __builtin_amdgcn_update_dpp(0, __builtin_bit_cast(int, x), 0x141, 0xf, 0xf, false));
    x += __builtin_bit_cast(float, __builtin_amdgcn_update_dpp(0, __builtin_bit_cast(int, x), 0x140, 0xf, 0xf, false));
    const int xi = __builtin_bit_cast(int, x);
    return (__builtin_bit_cast(float, __builtin_amdgcn_readlane(xi, 0)) + __builtin_bit_cast(float, __builtin_amdgcn_readlane(xi, 16)))
         + (__builtin_bit_cast(float, __builtin_amdgcn_readlane(xi, 32)) + __builtin_bit_cast(float, __builtin_amdgcn_readlane(xi, 48)));
}
DI int crow(int reg, int h) { return (reg & 3) + 8 * (reg >> 2) + 4 * h; }
#define MFMA32(a, b, c) __builtin_amdgcn_mfma_f32_32x32x16_bf16((a), (b), (c), 0, 0, 0)
DI bf16x8 tr_frag(const LAS unsigned char* base, int hi_off) {
    s16x4 lo = __builtin_amdgcn_ds_read_tr16_b64_v4i16((LAS s16x4*)base);
    s16x4 hi = __builtin_amdgcn_ds_read_tr16_b64_v4i16((LAS s16x4*)(base + hi_off));
    return __builtin_shufflevector(lo, hi, 0, 1, 2, 3, 4, 5, 6, 7);
}
DI int srccol(int which, int n) {
    if (which == 0) { if (n < 1536) return n; if (n < 3072) return n + 32; if (n < 3104) return n - 1536; return -1; }
    if (which == 2) { const int pn = n >> 8, bj = (n >> 7) & 1, cc = n & 127; return bj * FH + pn * 128 + cc; }
    return n;
}

namespace pg8 {
constexpr int BM = 256, BK = 64, HALF = 128, HTB = HALF * BK * 2, STAGE_BYTES = 8 * HTB, NXCD = 8, WGM = 8;
DI int lds_byte(int r, int c) { const int st = (r >> 4) * 2 + (c >> 5), rr = r & 15, cc = c & 31, ob = rr * 64 + cc * 2; return st * 1024 + (ob ^ (((ob >> 9) & 1) << 5)); }
DI void stage_rc(int b, int& R, int& C) { const int st = b / 1024, sb = b % 1024, swz = sb ^ (((sb >> 9) & 1) << 5); R = (st >> 1) * 16 + swz / 64; C = (st & 1) * 32 + (swz % 64) / 2; }
DI int perm32(int rho) { const int n = rho >> 4, i = rho & 15; return 8 * (i >> 2) + 4 * n + (i & 3); }
struct Unit { int pm, pn; };
struct Gemm { const bf16_t* A; const bf16_t* Bt; int M, N, K; };
struct StaticOrder {
    int nM, nN, nwg, G, c;
    DI void init(int M, int N, int G_, int c_) { nM = M / BM; nN = N / BM; nwg = nM * nN; G = G_; c = c_; }
    DI bool next(int i, Unit& u) const {
        const long L = (long)i * G + c; if (L >= nwg) return false;
        int wgid = (int)L; { const int q = nwg / NXCD, r = nwg % NXCD, xcd = wgid % NXCD, off = wgid / NXCD; wgid = (xcd < r ? xcd * (q + 1) : r * (q + 1) + (xcd - r) * q) + off; }
        const int nig = WGM * nN, gid = wgid / nig, fm = gid * WGM, gsz = (nM - fm) < WGM ? (nM - fm) : WGM;
        u.pm = fm + ((wgid % nig) % gsz); u.pn = (wgid % nig) / gsz; return true;
    }
    DI void a_ready(const Unit&) const {}
    DI void done(const Unit&) const {}
};
template <class Epi, class Sched, bool ALIGN_EPI = false, bool SP2 = false>
DI void gemm_phase(LAS unsigned char* lds, const Gemm g, const Sched& S, const Epi& E) {
    const int tid = my_tid(), wid = __builtin_amdgcn_readfirstlane(tid >> 6), lane = tid & 63, wr = wid >> 2, wc = wid & 3, fr = lane & 15, fq = lane >> 4;
    const int K = g.K, nt = K / BK;
    unsigned voffA[2], voffB[2];
#pragma unroll
    for (int i = 0; i < 2; ++i) { int R, C; stage_rc(tid * 16 + i * 8192, R, C); const int Rb = Epi::PERM ? ((R & ~31) + perm32(R & 31)) : R;
        voffA[i] = (unsigned)(R * K + C) * 2u; voffB[i] = (unsigned)(Rb * K + C) * 2u; }
    const size_t kstep = (size_t)(BK * 2);
    const size_t hstep = (size_t)HALF * K * 2;
    const size_t tstep = 2 * hstep;
    const unsigned ldsw = (unsigned)wid * 1024u;
    const int aoff = lds_byte(wr * 64 + fr, fq * 8), boff = lds_byte(wc * 32 + fr, fq * 8);
#define PG8_SA(b, h) (((b) * 2 + (h)) * HTB)
#define PG8_SB(b, h) ((4 + (b) * 2 + (h)) * HTB)
#define PG8_STAGE(bufoff, gbase, voff) do { _Pragma("unroll") for (int _i = 0; _i < 2; ++_i) \
        __builtin_amdgcn_global_load_lds((const unsigned*)((const char*)(gbase) + (voff)[_i]), (LAS unsigned*)(lds + (bufoff) + ldsw + _i * 8192), 16, 0, 0); } while (0)
#define PG8_LDA(dst, b, h) do { _Pragma("unroll") for (int m = 0; m < 4; ++m) _Pragma("unroll") for (int k = 0; k < 2; ++k) dst[m][k] = *(const LAS bf16x8*)(lds + PG8_SA(b, h) + aoff + m * 2048 + k * 1024); } while (0)
#define PG8_LDB(dst, b, h) do { _Pragma("unroll") for (int n = 0; n < 2; ++n) _Pragma("unroll") for (int k = 0; k < 2; ++k) dst[n][k] = *(const LAS bf16x8*)(lds + PG8_SB(b, h) + boff + n * 2048 + k * 1024); } while (0)
#define PG8_MMA(ai, bj, At, Bt) do { __builtin_amdgcn_s_setprio(1); _Pragma("unroll") for (int m = 0; m < 4; ++m) _Pragma("unroll") for (int n = 0; n < 2; ++n) _Pragma("unroll") for (int k = 0; k < 2; ++k) \
        acc[ai][bj][m][n] = __builtin_amdgcn_mfma_f32_16x16x32_bf16(Bt[n][k], At[m][k], acc[ai][bj][m][n], 0, 0, 0); __builtin_amdgcn_s_setprio(0); } while (0)
#define PG8_WAIT_V(n) asm volatile("s_waitcnt vmcnt(" #n ")" ::: "memory")
#define PG8_WAIT_L(n) asm volatile("s_waitcnt lgkmcnt(" #n ")" ::: "memory")
#define PG8_BAR __builtin_amdgcn_s_barrier()
#define PG8_SCHED __builtin_amdgcn_sched_barrier(0)
    Unit cur, nxt; int ui = 0;
    if (!S.next(0, cur)) return;
    f32x4 acc[2][2][4][2];
#pragma unroll
    for (int a = 0; a < 2; ++a)
#pragma unroll
        for (int b = 0; b < 2; ++b)
#pragma unroll
            for (int m = 0; m < 4; ++m)
#pragma unroll
                for (int n = 0; n < 2; ++n) acc[a][b][m][n] = (f32x4){0.f, 0.f, 0.f, 0.f};
    bf16x8 At[4][2], B0[2][2], B1[2][2];
    const char* cA = (const char*)g.A + (size_t)cur.pm * tstep; const char* cB = (const char*)g.Bt + (size_t)cur.pn * tstep;
    S.a_ready(cur);
    if constexpr (SP2) {
        PG8_STAGE(PG8_SB(0, 0), cB, voffB); PG8_STAGE(PG8_SB(0, 1), cB + hstep, voffB); PG8_STAGE(PG8_SA(0, 0), cA, voffA); PG8_STAGE(PG8_SA(0, 1), cA + hstep, voffA);
        if (wr == 1) PG8_BAR;
        PG8_WAIT_V(2); PG8_BAR;
        PG8_STAGE(PG8_SB(1, 0), cB + kstep, voffB); PG8_STAGE(PG8_SA(1, 0), cA + kstep, voffA); PG8_STAGE(PG8_SB(1, 1), cB + hstep + kstep, voffB);
        PG8_WAIT_V(6); PG8_BAR;
    } else {
        PG8_STAGE(PG8_SB(0, 0), cB, voffB); PG8_STAGE(PG8_SA(0, 0), cA, voffA); PG8_STAGE(PG8_SB(0, 1), cB + hstep, voffB); PG8_STAGE(PG8_SA(0, 1), cA + hstep, voffA);
        if (wr == 1) PG8_BAR;
        PG8_WAIT_V(4); PG8_BAR;
        PG8_STAGE(PG8_SB(1, 0), cB + kstep, voffB); PG8_STAGE(PG8_SA(1, 0), cA + kstep, voffA); PG8_STAGE(PG8_SB(1, 1), cB + hstep + kstep, voffB);
        PG8_WAIT_V(6); PG8_BAR;
    }
    for (;;) {
        const bool has_next = S.next(ui + 1, nxt);
        const char* nA = has_next ? (const char*)g.A + (size_t)nxt.pm * tstep : cA; const char* nB = has_next ? (const char*)g.Bt + (size_t)nxt.pn * tstep : cB;
        for (int t = 0; t < nt; t += 2) {
            const bool last = (t == nt - 2);
            const char* a1 = cA + (size_t)(t + 1) * kstep;
            const char* a2 = last ? nA : cA + (size_t)(t + 2) * kstep; const char* b2 = last ? nB : cB + (size_t)(t + 2) * kstep;
            const char* a3 = a2 + kstep; const char* b3 = b2 + kstep;
            if (last && has_next) S.a_ready(nxt);
            if constexpr (SP2) {
            PG8_LDB(B0, 0, 0); PG8_LDB(B1, 0, 1); PG8_SCHED; PG8_LDA(At, 0, 0); PG8_STAGE(PG8_SA(1, 1), a1 + hstep, voffA);
            PG8_WAIT_V(8); PG8_WAIT_L(0); PG8_BAR; PG8_MMA(0, 0, At, B0); PG8_MMA(0, 1, At, B1); PG8_BAR; PG8_SCHED;
            PG8_LDA(At, 0, 1); PG8_STAGE(PG8_SB(0, 0), b2, voffB); PG8_STAGE(PG8_SB(0, 1), b2 + hstep, voffB); PG8_STAGE(PG8_SA(0, 0), a2, voffA);
            PG8_WAIT_V(8); PG8_WAIT_L(0); PG8_BAR; PG8_MMA(1, 0, At, B0); PG8_MMA(1, 1, At, B1); PG8_BAR; PG8_SCHED;
            PG8_LDB(B0, 1, 0); PG8_LDB(B1, 1, 1); PG8_SCHED; PG8_LDA(At, 1, 0); PG8_STAGE(PG8_SA(0, 1), a2 + hstep, voffA);
            PG8_WAIT_V(8); PG8_WAIT_L(0); PG8_BAR; PG8_MMA(0, 0, At, B0); PG8_MMA(0, 1, At, B1); PG8_BAR; PG8_SCHED;
            PG8_LDA(At, 1, 1); PG8_STAGE(PG8_SB(1, 0), b3, voffB); PG8_STAGE(PG8_SB(1, 1), b3 + hstep, voffB); PG8_STAGE(PG8_SA(1, 0), a3, voffA);
            PG8_WAIT_V(8); PG8_WAIT_L(0); PG8_BAR; PG8_MMA(1, 0, At, B0); PG8_MMA(1, 1, At, B1); PG8_BAR; PG8_SCHED;
            } else {
            PG8_LDB(B0, 0, 0); PG8_SCHED; PG8_LDA(At, 0, 0); PG8_STAGE(PG8_SA(1, 1), a1 + hstep, voffA);
            PG8_WAIT_L(8); PG8_BAR; PG8_WAIT_L(0); PG8_MMA(0, 0, At, B0); PG8_BAR; PG8_SCHED;
            PG8_LDB(B1, 0, 1); PG8_STAGE(PG8_SB(0, 0), b2, voffB);
            PG8_BAR; PG8_WAIT_L(0); PG8_MMA(0, 1, At, B1); PG8_BAR;
            PG8_LDA(At, 0, 1); PG8_STAGE(PG8_SA(0, 0), a2, voffA);
            PG8_BAR; PG8_WAIT_L(0); PG8_MMA(1, 0, At, B0); PG8_BAR; PG8_SCHED;
            PG8_STAGE(PG8_SB(0, 1), b2 + hstep, voffB);
            PG8_WAIT_V(6); PG8_BAR; PG8_MMA(1, 1, At, B1); PG8_BAR;
            PG8_LDB(B0, 1, 0); PG8_SCHED; PG8_LDA(At, 1, 0); PG8_STAGE(PG8_SA(0, 1), a2 + hstep, voffA);
            PG8_WAIT_L(8); PG8_BAR; PG8_WAIT_L(0); PG8_MMA(0, 0, At, B0); PG8_BAR; PG8_SCHED;
            PG8_LDB(B1, 1, 1); PG8_STAGE(PG8_SB(1, 0), b3, voffB);
            PG8_BAR; PG8_WAIT_L(0); PG8_MMA(0, 1, At, B1); PG8_BAR;
            PG8_LDA(At, 1, 1); PG8_STAGE(PG8_SA(1, 0), a3, voffA);
            PG8_BAR; PG8_WAIT_L(0); PG8_MMA(1, 0, At, B0); PG8_BAR; PG8_SCHED;
            PG8_STAGE(PG8_SB(1, 1), b3 + hstep, voffB);
            PG8_WAIT_V(6); PG8_BAR; PG8_MMA(1, 1, At, B1); PG8_BAR;
            }
        }
        if constexpr (ALIGN_EPI) { if (wr == 0) PG8_BAR; }
        E(acc, cur, wr, wc, fr, fq);
        if (!has_next) break;
#pragma unroll
        for (int a = 0; a < 2; ++a)
#pragma unroll
            for (int b = 0; b < 2; ++b)
#pragma unroll
                for (int m = 0; m < 4; ++m)
#pragma unroll
                    for (int n = 0; n < 2; ++n) acc[a][b][m][n] = (f32x4){0.f, 0.f, 0.f, 0.f};
        cur = nxt; cA = nA; cB = nB; ++ui;
        if constexpr (ALIGN_EPI) { if (wr == 1) PG8_BAR; }
    }
    PG8_WAIT_V(0);
    if constexpr (!ALIGN_EPI) { if (wr == 0) PG8_BAR; }
    PG8_BAR;
#undef PG8_SA
#undef PG8_SB
#undef PG8_STAGE
#undef PG8_LDA
#undef PG8_LDB
#undef PG8_MMA
#undef PG8_WAIT_V
#undef PG8_WAIT_L
#undef PG8_BAR
#undef PG8_SCHED
}
}

typedef f32x4 AccT[2][2][4][2];

struct EpiInProj {
    static constexpr bool PERM = true;
    bf16_t* P; float* GD;
    DI void operator()(const AccT& acc, const pg8::Unit& u, int wr, int wc, int fr, int fq) const {
        const int row0 = u.pm * 256 + wr * 64 + fr;
        if (u.pn < 12) {
            const int col0 = u.pn * 256 + wc * 32 + 8 * fq;
#pragma unroll
            for (int ai = 0; ai < 2; ++ai)
#pragma unroll
                for (int m = 0; m < 4; ++m) { bf16_t* rowp = P + (size_t)(row0 + ai * 128 + m * 16) * PW + col0;
#pragma unroll
                    for (int bj = 0; bj < 2; ++bj) { const f32x4 v0 = acc[ai][bj][m][0], v1 = acc[ai][bj][m][1];
                        u32x4 w; w.x = pk_bf16(v0[0], v0[1]); w.y = pk_bf16(v0[2], v0[3]); w.z = pk_bf16(v1[0], v1[1]); w.w = pk_bf16(v1[2], v1[3]);
                        *(u32x4*)(rowp + bj * 128) = w; } }
        } else if (wc == 0) {
#pragma unroll
            for (int ai = 0; ai < 2; ++ai)
#pragma unroll
                for (int m = 0; m < 4; ++m) { float* rowp = GD + (size_t)(row0 + ai * 128 + m * 16) * 32 + 8 * fq;
                    *(f32x4*)(rowp) = acc[ai][0][m][0]; *(f32x4*)(rowp + 4) = acc[ai][0][m][1]; }
        }
    }
};
struct EpiOutProj {
    static constexpr bool PERM = true;
    const float* x; const float* mod; const float* n2g; float* out; bf16_t* H2; float* rowss;
    DI void operator()(const AccT& acc, const pg8::Unit& u, int wr, int wc, int fr, int fq) const {
        const int row0 = u.pm * 256 + wr * 64 + fr; const int b = (u.pm * 256) >> 13;
        const float* mb = mod + b * 6144;
#pragma unroll
        for (int ai = 0; ai < 2; ++ai)
#pragma unroll
            for (int m = 0; m < 4; ++m) { const int row = row0 + ai * 128 + m * 16; float ss = 0.f;
#pragma unroll
                for (int bj = 0; bj < 2; ++bj) { const int c0 = u.pn * 256 + bj * 128 + wc * 32 + 8 * fq; const size_t off = (size_t)row * D + c0;
                    unsigned w[4];
#pragma unroll
                    for (int n = 0; n < 2; ++n) { const f32x4 xv = *(const f32x4*)(x + off + 4 * n); const f32x4 gt = *(const f32x4*)(mb + 2048 + c0 + 4 * n);
                        const f32x4 sc = *(const f32x4*)(mb + 4096 + c0 + 4 * n); const f32x4 gg = *(const f32x4*)(n2g + c0 + 4 * n);
                        const f32x4 x1 = xv + gt * acc[ai][bj][m][n]; *(f32x4*)(out + off + 4 * n) = x1;
                        ss += (x1[0] * x1[0] + x1[1] * x1[1]) + (x1[2] * x1[2] + x1[3] * x1[3]);
                        const f32x4 hv = x1 * gg * (sc + 1.0f); w[2 * n] = pk_bf16(hv[0], hv[1]); w[2 * n + 1] = pk_bf16(hv[2], hv[3]); }
                    u32x4 ww; ww.x = w[0]; ww.y = w[1]; ww.z = w[2]; ww.w = w[3]; *(u32x4*)(H2 + off) = ww; }
                ss += __shfl_xor(ss, 16); ss += __shfl_xor(ss, 32);
                if (fq == 0) atomicAdd(rowss + row, ss); }
    }
};
struct EpiFfnIn {
    static constexpr bool PERM = true;
    const float* rowss; const float* bias2; bf16_t* ACT;
    DI void operator()(const AccT& acc, const pg8::Unit& u, int wr, int wc, int fr, int fq) const {
        const int row0 = u.pm * 256 + wr * 64 + fr; const int b = (u.pm * 256) >> 13;
        const float* bb = bias2 + b * FH2 + u.pn * 256 + wc * 32 + 8 * fq;
        f32x4 bg[2], bu[2];
#pragma unroll
        for (int n = 0; n < 2; ++n) { bg[n] = *(const f32x4*)(bb + 4 * n); bu[n] = *(const f32x4*)(bb + 128 + 4 * n); }
#pragma unroll
        for (int ai = 0; ai < 2; ++ai)
#pragma unroll
            for (int m = 0; m < 4; ++m) { const int row = row0 + ai * 128 + m * 16; const float rs = rsqrtf(rowss[row] * (1.0f / 1024.0f) + EPS);
                unsigned w[4];
#pragma unroll
                for (int n = 0; n < 2; ++n) { const f32x4 gt = acc[ai][0][m][n] * rs + bg[n]; const f32x4 up = acc[ai][1][m][n] * rs + bu[n];
                    const f32x4 t = gt * (-1.4426950409f);
                    f32x4 dn_ = {__builtin_amdgcn_exp2f(t[0]), __builtin_amdgcn_exp2f(t[1]), __builtin_amdgcn_exp2f(t[2]), __builtin_amdgcn_exp2f(t[3])};
                    dn_ = dn_ + 1.0f;
                    const f32x4 rc = {__builtin_amdgcn_rcpf(dn_[0]), __builtin_amdgcn_rcpf(dn_[1]), __builtin_amdgcn_rcpf(dn_[2]), __builtin_amdgcn_rcpf(dn_[3])};
                    const f32x4 o = (gt * up) * rc;
                    w[2 * n] = pk_bf16(o[0], o[1]); w[2 * n + 1] = pk_bf16(o[2], o[3]); }
                u32x4 ww; ww.x = w[0]; ww.y = w[1]; ww.z = w[2]; ww.w = w[3];
                *(u32x4*)(ACT + (size_t)row * FH + u.pn * 128 + wc * 32 + 8 * fq) = ww; }
    }
};
struct EpiFfnOut {
    static constexpr bool PERM = true;
    const float* mod; float* out;
    DI void operator()(const AccT& acc, const pg8::Unit& u, int wr, int wc, int fr, int fq) const {
        const int row0 = u.pm * 256 + wr * 64 + fr; const int b = (u.pm * 256) >> 13;
        const float* mb = mod + b * 6144 + 5120;
#pragma unroll
        for (int ai = 0; ai < 2; ++ai)
#pragma unroll
            for (int m = 0; m < 4; ++m) { const int row = row0 + ai * 128 + m * 16;
#pragma unroll
                for (int bj = 0; bj < 2; ++bj) { const int c0 = u.pn * 256 + bj * 128 + wc * 32 + 8 * fq; const size_t off = (size_t)row * D + c0;
#pragma unroll
                    for (int n = 0; n < 2; ++n) { const f32x4 xv = *(const f32x4*)(out + off + 4 * n); const f32x4 gt = *(const f32x4*)(mb + c0 + 4 * n);
                        *(f32x4*)(out + off + 4 * n) = xv + gt * acc[ai][bj][m][n]; } } }
    }
};

DI void adaln_item(const Params& p, int item, LAS unsigned char* lds, float* mod) {
    const int tid = my_tid();
    LAS float* scond = (LAS float*)lds;
    LAS float* red = scond + 5 * 1024;
    for (int i = tid; i < 5 * 1024; i += NTHR) { const int b = i >> 10, k = i & 1023; const float v = b < 4 ? p.c[b * 1024 + k] : p.c_ctx[k]; scond[i] = silu_f(v); }
    __syncthreads();
    const int cl = tid & 31, kg = tid >> 5, col = item * 32 + cl;
    float a0 = 0.f, a1 = 0.f, a2 = 0.f, a3 = 0.f, a4 = 0.f;
    for (int k8 = 0; k8 < 64; k8 += 8) { float wv[8];
#pragma unroll
        for (int u = 0; u < 8; ++u) wv[u] = p.w_mod[(size_t)(kg * 64 + k8 + u) * 6144 + col];
#pragma unroll
        for (int u = 0; u < 8; ++u) { const int k = kg * 64 + k8 + u; const float w = wv[u];
            a0 += scond[k] * w; a1 += scond[1024 + k] * w; a2 += scond[2048 + k] * w; a3 += scond[3072 + k] * w; a4 += scond[4096 + k] * w; } }
    LAS float* rp = red + (kg * 32 + cl) * 5; rp[0] = a0; rp[1] = a1; rp[2] = a2; rp[3] = a3; rp[4] = a4;
    __syncthreads();
    if (tid < 160) { const int b = tid >> 5, c2 = tid & 31; float s_ = p.b_mod[item * 32 + c2];
#pragma unroll
        for (int g = 0; g < 16; ++g) s_ += red[(g * 32 + c2) * 5 + b];
        mod[b * 6144 + item * 32 + c2] = s_; }
    __syncthreads();
}
DI void transpose_item(const float* src, int ldn, bf16_t* dst, int K, int k0, int n0, int which, LAS unsigned char* lds) {
    const int tid = my_tid(); LAS float* t = (LAS float*)lds;
#pragma unroll
    for (int i = 0; i < 2; ++i) { const int kk = (tid >> 4) + 32 * i, nn = (tid & 15) * 4, n = n0 + nn; const int sc = srccol(which, n);
        f32x4 v = sc >= 0 ? *(const f32x4*)(src + (size_t)(k0 + kk) * ldn + sc) : (f32x4){0.f, 0.f, 0.f, 0.f}; if (which == 0 && n < 256) v = v * 0.125f;
        *(LAS f32x4*)(t + kk * 68 + nn) = v; }
    __syncthreads();
    { const int nn = tid >> 3, kc = tid & 7; u32x4 w;
      w.x = pk_bf16(t[(kc * 8 + 0) * 68 + nn], t[(kc * 8 + 1) * 68 + nn]); w.y = pk_bf16(t[(kc * 8 + 2) * 68 + nn], t[(kc * 8 + 3) * 68 + nn]);
      w.z = pk_bf16(t[(kc * 8 + 4) * 68 + nn], t[(kc * 8 + 5) * 68 + nn]); w.w = pk_bf16(t[(kc * 8 + 6) * 68 + nn], t[(kc * 8 + 7) * 68 + nn]);
      *(u32x4*)(dst + (size_t)(n0 + nn) * K + k0 + kc * 8) = w; }
    __syncthreads();
}
DI void phase0(const Params& p, LAS unsigned char* lds) {
    unsigned char* ws = p.ws; const int tid = my_tid();
    float* mod = (float*)(ws + WS_MOD);
    constexpr int N_ADA = 192, T_IN = 16 * 52, T_OUT = 16 * 16, T_F1 = 16 * 88, T_F2 = 44 * 16, N_ZERO = 27;
    constexpr int O1 = N_ADA, O2 = O1 + T_IN, O3 = O2 + T_OUT, O4 = O3 + T_F1, O5 = O4 + T_F2, O6 = O5 + 1, TOT = O6 + N_ZERO;
    for (int it = blockIdx.x; it < TOT; it += gridDim.x) {
        if (it < O1) adaln_item(p, it, lds, mod);
        else if (it < O2) { const int j = it - O1; transpose_item(p.w_in, 3104, (bf16_t*)(ws + WS_WIN), D, (j & 15) * 64, (j >> 4) * 64, 0, lds); }
        else if (it < O3) { const int j = it - O2; transpose_item(p.w_out, D, (bf16_t*)(ws + WS_WOUT), D, (j & 15) * 64, (j >> 4) * 64, 1, lds); }
        else if (it < O4) { const int j = it - O3; transpose_item(p.w_ffn_in, FH2, (bf16_t*)(ws + WS_WF1), D, (j & 15) * 64, (j >> 4) * 64, 2, lds); }
        else if (it < O5) { const int j = it - O4; transpose_item(p.w_ffn_out, D, (bf16_t*)(ws + WS_WF2), FH, (j % 44) * 64, (j / 44) * 64, 3, lds); }
        else if (it < O6) {
            f32x2* tab = (f32x2*)(ws + WS_ROPE);
            for (int idx = tid; idx < 2048; idx += NTHR) { const int pos = idx >> 4, f = idx & 15; const float inv = powf(10000.0f, -(float)f / 16.0f); const float ang = (float)pos * inv;
                tab[idx] = (f32x2){cosf(ang), sinf(ang)}; }
            if (tid == 0) { float s0 = 0.f, s1 = 0.f, mq = 0.f, mk = 0.f;
                for (int i = 0; i < 64; ++i) { s0 += p.lam_q[i] * p.lam_k[i]; s1 += p.lam_q[64 + i] * p.lam_k[64 + i]; mq = fmaxf(mq, fabsf(p.q_norm_g[i])); mk = fmaxf(mk, fabsf(p.k_norm_g[i])); }
                float* ctl = (float*)(ws + WS_CTL); ctl[0] = expf(s0) - expf(s1) + 0.2f;
                ctl[1] = 8.0f * 1.4426950409f * mq * mk * 1.02f + 0.25f; }
        } else { const int j = it - O6; const int idx = j * 2048 + tid * 4;
            if (idx < NLAT) *(f32x4*)((float*)(ws + WS_ROWSS) + idx) = (f32x4){0.f, 0.f, 0.f, 0.f};
            else if (idx - NLAT < NB * FH2) *(f32x4*)((float*)(ws + WS_BIAS2) + (idx - NLAT)) = (f32x4){0.f, 0.f, 0.f, 0.f}; }
    }
}

DI void phase1(const Params& p) {
    unsigned char* ws = p.ws; const int tid = my_tid(), lane = tid & 63, wave = tid >> 6;
    const float* mod = (const float*)(ws + WS_MOD); bf16_t* H = (bf16_t*)(ws + WS_H); float* bias2 = (float*)(ws + WS_BIAS2);
    constexpr int N_ROW = NT / 16, N_B2 = 22 * 16;
    for (int it = blockIdx.x; it < N_ROW + N_B2; it += gridDim.x) {
        if (it < N_ROW) {
            const float* src[2]; const float* mb[2]; f32x4 v[2][4]; float ss[2];
#pragma unroll
            for (int u = 0; u < 2; ++u) { const int row = it * 16 + wave * 2 + u;
                if (row < NLAT) { src[u] = p.x + (size_t)row * D; mb[u] = mod + (row >> 13) * 6144; } else { src[u] = p.ctx + (size_t)(row - NLAT) * D; mb[u] = mod + 4 * 6144; }
#pragma unroll
                for (int i = 0; i < 4; ++i) v[u][i] = *(const f32x4*)(src[u] + 4 * lane + 256 * i); }
#pragma unroll
            for (int u = 0; u < 2; ++u) { ss[u] = 0.f;
#pragma unroll
                for (int i = 0; i < 4; ++i) ss[u] += (v[u][i][0] * v[u][i][0] + v[u][i][1] * v[u][i][1]) + (v[u][i][2] * v[u][i][2] + v[u][i][3] * v[u][i][3]);
                ss[u] = wave_allreduce_sum(ss[u]); }
#pragma unroll
            for (int u = 0; u < 2; ++u) { const int row = it * 16 + wave * 2 + u; const float rs = rsqrtf(ss[u] * (1.0f / 1024.0f) + EPS);
#pragma unroll
                for (int i = 0; i < 4; ++i) { const int c = 4 * lane + 256 * i; const f32x4 g = *(const f32x4*)(p.norm1_g + c), sh = *(const f32x4*)(mb[u] + c), sc = *(const f32x4*)(mb[u] + 1024 + c);
                    const f32x4 h = v[u][i] * rs * g * (sc + 1.0f) + sh; u32x2 w; w.x = pk_bf16(h[0], h[1]); w.y = pk_bf16(h[2], h[3]); *(u32x2*)(H + (size_t)row * D + c) = w; } }
        } else {
            const int idx = it - N_ROW, nb = idx % 22, kc = idx / 22; const int nn = tid & 255, half = tid >> 8; const int n = nb * 256 + nn, sc = srccol(2, n);
            float a0 = 0.f, a1 = 0.f, a2 = 0.f, a3 = 0.f;
            for (int kk = 0; kk < 32; ++kk) { const int k = kc * 64 + half * 32 + kk; const float w = p.w_ffn_in[(size_t)k * FH2 + sc];
                a0 += mod[3072 + k] * w; a1 += mod[6144 + 3072 + k] * w; a2 += mod[2 * 6144 + 3072 + k] * w; a3 += mod[3 * 6144 + 3072 + k] * w; }
            atomicAdd(bias2 + n, a0); atomicAdd(bias2 + FH2 + n, a1); atomicAdd(bias2 + 2 * FH2 + n, a2); atomicAdd(bias2 + 3 * FH2 + n, a3);
        }
    }
}

#define DPPF(x, ctrl) __builtin_bit_cast(float, __builtin_amdgcn_update_dpp(0, __builtin_bit_cast(int, (x)), (ctrl), 0xf, 0xf, false))
DI void qknorm_item(const Params& p, int item) {
    unsigned char* ws = p.ws; const int tid = my_tid(); bf16_t* P = (bf16_t*)(ws + WS_P); const f32x2* tab = (const f32x2*)(ws + WS_ROPE);
    const int sub = tid & 63, j = sub & 7;
    const float* gsrc = p.k_norm_g + 8 * j;
    float g[8];
#pragma unroll
    for (int e = 0; e < 8; ++e) g[e] = gsrc[e];
    const int axis = j >> 2, half = (j >> 1) & 1, f0 = 8 * (j & 1);
    u32x4 raws[8];
#pragma unroll
    for (int u = 0; u < 8; ++u) raws[u] = *(const u32x4*)(P + (size_t)(item * 64 + u * 8 + (tid >> 6)) * PW + C_DK + sub * 8);
#pragma unroll
    for (int u = 0; u < 8; ++u) {
        const int row = item * 64 + u * 8 + (tid >> 6);
        bf16_t* ptr = P + (size_t)row * PW + C_DK + sub * 8;
        const u32x4 raw = raws[u];
        float v[8]; v[0] = bf_lo(raw.x); v[1] = bf_hi(raw.x); v[2] = bf_lo(raw.y); v[3] = bf_hi(raw.y); v[4] = bf_lo(raw.z); v[5] = bf_hi(raw.z); v[6] = bf_lo(raw.w); v[7] = bf_hi(raw.w);
        float ss = 0.f;
#pragma unroll
        for (int e = 0; e < 8; ++e) ss += v[e] * v[e];
        ss += DPPF(ss, 0xB1); ss += DPPF(ss, 0x4E); ss += DPPF(ss, 0x141);
        const float rs = rsqrtf(ss * (1.0f / 64.0f) + EPS);
#pragma unroll
        for (int e = 0; e < 8; ++e) v[e] = v[e] * rs * g[e];
        if (row < NLAT) {
            const int t = row & (SEQ - 1); const int pos = axis ? (t & 63) : (t >> 6);
#pragma unroll
            for (int e = 0; e < 8; ++e) { const float o = DPPF(v[e], 0x4E); const f32x2 cs = tab[pos * 16 + f0 + e];
                v[e] = half ? (v[e] * cs.x + o * cs.y) : (v[e] * cs.x - o * cs.y); }
        }
        u32x4 w; w.x = pk_bf16(v[0], v[1]); w.y = pk_bf16(v[2], v[3]); w.z = pk_bf16(v[4], v[5]); w.w = pk_bf16(v[6], v[7]);
        *(u32x4*)ptr = w;
    }
}


#define DPP_ADD(x, ctrl) ((x) + __builtin_bit_cast(float, __builtin_amdgcn_update_dpp(0, __builtin_bit_cast(int, (x)), (ctrl), 0xf, 0xf, false)))
DI float scan_prefix64(float x, int lane) {
    x = DPP_ADD(x, 0x111); x = DPP_ADD(x, 0x112); x = DPP_ADD(x, 0x114); x = DPP_ADD(x, 0x118);
    asm volatile("s_nop 1\n\tv_add_f32_dpp %0, %0, %0 row_bcast:15 row_mask:0xa bank_mask:0xf" : "+v"(x));
    asm volatile("s_nop 1\n\tv_add_f32_dpp %0, %0, %0 row_bcast:31 row_mask:0xc bank_mask:0xf" : "+v"(x));
    return x;
}
DI float scan_suffix64(float x, int lane) {
    const float pre = scan_prefix64(x, lane);
    const float tot = __builtin_bit_cast(float, __builtin_amdgcn_readlane(__builtin_bit_cast(int, pre), 63));
    return (tot - pre) + x;
}
#define GLA_GATES(dir, g)                                                                                                           \
    do {                                                                                                                           \
        f32x2 z2_[4];                                                                                                               \
        _Pragma("unroll") for (int c2 = 0; c2 < 4; ++c2) z2_[c2] = *(const f32x2*)(p.gate_bias + (dir) * 256 + h * 64 + ch0 + 2 * c2) * 1.4426950409f; \
        _Pragma("unroll") for (int rr = 0; rr < 16; ++rr) {                                                                         \
            const f32x4 ga_ = *(const LAS f32x4*)(GU + ((dir) * 16 + rr) * 64 + ch0), gb_ = *(const LAS f32x4*)(GU + ((dir) * 16 + rr) * 64 + ch0 + 4); \
            const f32x2 dv_ = {dn[(dir) * 16 + rr], dn[(dir) * 16 + rr]};                                                           \
            z2_[0] += dv_ * (f32x2){ga_[0], ga_[1]}; z2_[1] += dv_ * (f32x2){ga_[2], ga_[3]};                                       \
            z2_[2] += dv_ * (f32x2){gb_[0], gb_[1]}; z2_[3] += dv_ * (f32x2){gb_[2], gb_[3]};                                       \
        }                                                                                                                          \
        _Pragma("unroll") for (int c = 0; c < 8; ++c) g[c] = logsig2_16(z2_[c >> 1][c & 1]);                                        \
        _Pragma("unroll") for (int c = 0; c < 8; ++c) g[c] = (dir) == 0 ? scan_prefix64(g[c], lane) : scan_suffix64(g[c], lane);             \
    } while (0)

DI void gla_a_pair(const Params& p, LAS unsigned char* lds0, int jA, int jB) {
    unsigned char* ws = p.ws; const int tid = my_tid(), lane = tid & 63, wave = __builtin_amdgcn_readfirstlane(tid >> 6);
    const int half = wave >> 2, w4 = wave & 3, tidh = tid & 255;
    const int j = half ? jB : jA; const int b = j / (4 * NPOS), h = (j / NPOS) & 3, cc = j % NPOS;
    LAS unsigned char* lds = lds0 + half * 53248;
    const bf16_t* P = (const bf16_t*)(ws + WS_P); const float* GDp = (const float*)(ws + WS_GD); bf16_t* DS = (bf16_t*)(ws + WS_DS); float* DEC = (float*)(ws + WS_DEC);
    const int row0 = cc < 4 ? NLAT + b * CTXL + cc * 64 : b * SEQ + (cc - 4) * 64;
    LAS float* GU = (LAS float*)lds;
    LAS unsigned char* KI0 = lds + 8192;
    LAS unsigned char* KI1 = lds + 8192 + 12288;
    LAS unsigned char* VI = lds + 8192 + 24576;
#pragma unroll
    for (int i = 0; i < 8; ++i) { const int idx = tidh + 256 * i; const int dir = idx >> 10, rr = (idx >> 6) & 15, c = idx & 63; GU[idx] = p.gate_up[(dir * 16 + rr) * 256 + h * 64 + c] * 1.4426950409f; }
#pragma unroll
    for (int i = 0; i < 4; ++i) { const int id = tidh + 256 * i, row = id >> 4, c16 = id & 15;
        *(LAS u32x4*)(VI + row * 320 + c16 * 16) = *(const u32x4*)(P + (size_t)(row0 + row) * PW + C_GV + h * 128 + c16 * 8); }
    float dn[32];
#pragma unroll
    for (int i = 0; i < 8; ++i) { const f32x4 t = *(const f32x4*)(GDp + (size_t)(row0 + lane) * 32 + 4 * i); dn[4 * i] = t[0]; dn[4 * i + 1] = t[1]; dn[4 * i + 2] = t[2]; dn[4 * i + 3] = t[3]; }
    u32x4 kraw2[2], qraw2[2];
#pragma unroll
    for (int cb = 0; cb < 2; ++cb) { kraw2[cb] = *(const u32x4*)(P + (size_t)(row0 + lane) * PW + C_GK + h * 64 + 16 * w4 + 8 * cb);
        qraw2[cb] = *(const u32x4*)(P + (size_t)(row0 + lane) * PW + (cc >= 4 ? C_GQ : C_GK) + h * 64 + 16 * w4 + 8 * cb); }
    __syncthreads();
    const int seq0 = (b * 4 + h) * 2;
    const int pos0 = cc, pos1 = cc < 4 ? 3 - cc : 135 - cc;
#pragma unroll
    for (int cb = 0; cb < 2; ++cb) {
        const int ch0 = 16 * w4 + 8 * cb;
        const u32x4 kraw = kraw2[cb], qraw = qraw2[cb];
        float kf[8]; kf[0] = bf_lo(kraw.x); kf[1] = bf_hi(kraw.x); kf[2] = bf_lo(kraw.y); kf[3] = bf_hi(kraw.y); kf[4] = bf_lo(kraw.z); kf[5] = bf_hi(kraw.z); kf[6] = bf_lo(kraw.w); kf[7] = bf_hi(kraw.w);
        float qf8[8]; qf8[0] = bf_lo(qraw.x); qf8[1] = bf_hi(qraw.x); qf8[2] = bf_lo(qraw.y); qf8[3] = bf_hi(qraw.y); qf8[4] = bf_lo(qraw.z); qf8[5] = bf_hi(qraw.z); qf8[6] = bf_lo(qraw.w); qf8[7] = bf_hi(qraw.w);
        bf16_t* QKT = (bf16_t*)(ws + WS_H) + ((size_t)((b * 4 + h) * 128 + (cc - 4)) * 4) * 4096 + lane * 64 + ch0;
#pragma unroll
        for (int dir = 0; dir < 2; ++dir) {
            float g[8]; GLA_GATES(dir, g);
            float kh[8];
            float eg[8], ieg[8], et[8];
#pragma unroll
            for (int c = 0; c < 8; ++c) { const float tot = __builtin_bit_cast(float, __builtin_amdgcn_readlane(__builtin_bit_cast(int, g[c]), dir == 0 ? 63 : 0)); et[c] = __builtin_amdgcn_exp2f(tot); eg[c] = __builtin_amdgcn_exp2f(g[c]); ieg[c] = __builtin_amdgcn_exp2f(fminf(-g[c], 86.0f)); kh[c] = (kf[c] * ieg[c]) * et[c]; }
            if (lane == 0) { float* dp = DEC + ((size_t)(seq0 + dir) * NPOS + (dir == 0 ? pos0 : pos1)) * 64 + ch0;
                *(f32x4*)dp = (f32x4){et[0], et[1], et[2], et[3]}; *(f32x4*)(dp + 4) = (f32x4){et[4], et[5], et[6], et[7]}; }
            u32x4 w; w.x = pk_bf16(kh[0], kh[1]); w.y = pk_bf16(kh[2], kh[3]); w.z = pk_bf16(kh[4], kh[5]); w.w = pk_bf16(kh[6], kh[7]);
            *(LAS u32x4*)((dir == 0 ? KI0 : KI1) + lane * 192 + ch0 * 2) = w;
            if (cc >= 4) {
                float qt[8], kt[8];
#pragma unroll
                for (int c = 0; c < 8; ++c) { qt[c] = qf8[c] * eg[c]; kt[c] = kf[c] * ieg[c]; }
                u32x4 wq, wk; wq.x = pk_bf16(qt[0], qt[1]); wq.y = pk_bf16(qt[2], qt[3]); wq.z = pk_bf16(qt[4], qt[5]); wq.w = pk_bf16(qt[6], qt[7]);
                wk.x = pk_bf16(kt[0], kt[1]); wk.y = pk_bf16(kt[2], kt[3]); wk.z = pk_bf16(kt[4], kt[5]); wk.w = pk_bf16(kt[6], kt[7]);
                *(u32x4*)(QKT + (dir * 2 + 0) * 4096) = wq; *(u32x4*)(QKT + (dir * 2 + 1) * 4096) = wk;
            }
        }
    }
    __syncthreads();
    const int r = lane & 31, hh = lane >> 5, q = (lane & 15) >> 2, pc = lane & 3, blk = (lane >> 4) & 1;
    const int dkt = w4 & 1, dv2 = (w4 >> 1) * 2;
    f32x16 af0 = {}, af1 = {}, ab0 = {}, ab1 = {};
#pragma unroll
    for (int s_ = 0; s_ < 4; ++s_) {
        const bf16x8 b0 = tr_frag(VI + (16 * s_ + 8 * hh + q) * 320 + dv2 * 64 + 32 * blk + 8 * pc, 4 * 320);
        const bf16x8 b1 = tr_frag(VI + (16 * s_ + 8 * hh + q) * 320 + (dv2 + 1) * 64 + 32 * blk + 8 * pc, 4 * 320);
        const bf16x8 a0 = tr_frag(KI0 + (16 * s_ + 8 * hh + q) * 192 + dkt * 64 + 32 * blk + 8 * pc, 4 * 192);
        const bf16x8 a1 = tr_frag(KI1 + (16 * s_ + 8 * hh + q) * 192 + dkt * 64 + 32 * blk + 8 * pc, 4 * 192);
        af0 = MFMA32(a0, b0, af0); af1 = MFMA32(a0, b1, af1); ab0 = MFMA32(a1, b0, ab0); ab1 = MFMA32(a1, b1, ab1);
    }
    bf16_t* o0 = DS + ((size_t)(seq0 + 0) * NPOS + pos0) * 8192 + (dkt * 32) * 128 + dv2 * 32 + r;
    bf16_t* o1 = DS + ((size_t)(seq0 + 1) * NPOS + pos1) * 8192 + (dkt * 32) * 128 + dv2 * 32 + r;
#pragma unroll
    for (int i = 0; i < 16; ++i) { const int dk = crow(i, hh);
        const unsigned wf = pk_bf16(af0[i], af1[i]), wb = pk_bf16(ab0[i], ab1[i]);
        o0[dk * 128] = (bf16_t)(wf & 0xffffu); o0[dk * 128 + 32] = (bf16_t)(wf >> 16);
        o1[dk * 128] = (bf16_t)(wb & 0xffffu); o1[dk * 128 + 32] = (bf16_t)(wb >> 16); }
    __syncthreads();
}

DI void gla_b(const Params& p) {
    unsigned char* ws = p.ws; unsigned* DS = (unsigned*)(ws + WS_DS); const float* DEC = (const float*)(ws + WS_DEC);
    const int nthr = gridDim.x * NTHR;
    for (int e = blockIdx.x * NTHR + my_tid(); e < 32 * 64 * 64; e += nthr) {
        const int seq = e >> 12, dk = (e >> 6) & 63, dvp = e & 63;
        unsigned* base = DS + (size_t)seq * NPOS * 4096 + dk * 64 + dvp; const float* dec = DEC + (size_t)seq * NPOS * 64 + dk;
        float s0 = 0.f, s1 = 0.f;
        for (int pp = 0; pp < NPOS; pp += 12) {
            unsigned raw[12]; float d[12];
#pragma unroll
            for (int u = 0; u < 12; ++u) { raw[u] = base[(size_t)(pp + u) * 4096]; d[u] = dec[(pp + u) * 64]; }
#pragma unroll
            for (int u = 0; u < 12; ++u) { base[(size_t)(pp + u) * 4096] = pk_bf16(s0, s1); s0 = d[u] * s0 + bf_lo(raw[u]); s1 = d[u] * s1 + bf_hi(raw[u]); }
        }
    }
}

DI void gla_c_item(const Params& p, LAS unsigned char* lds, int b, int h, int c) {
    unsigned char* ws = p.ws; const int tid = my_tid(), lane = tid & 63, wave = __builtin_amdgcn_readfirstlane(tid >> 6);
    const bf16_t* P = (const bf16_t*)(ws + WS_P); const float* GDp = (const float*)(ws + WS_GD); const bf16_t* DS = (const bf16_t*)(ws + WS_DS); bf16_t* MIX = (bf16_t*)(ws + WS_MIX);
    const int row0 = b * SEQ + c * 64; const int ch0 = 8 * wave;
    LAS float* GU = (LAS float*)lds;
    LAS unsigned char* QI0 = lds + 8192;
    LAS unsigned char* KI0 = lds + 8192 + 9216;
    LAS unsigned char* QI1 = lds + 8192 + 2 * 9216;
    LAS unsigned char* KI1 = lds + 8192 + 3 * 9216;
    LAS unsigned char* VI = lds + 45056;
    LAS unsigned char* SI0 = lds + 65536;
    LAS unsigned char* SI1 = lds + 86016;
    LAS float* RED = (LAS float*)(lds + 106496);
    const int seq0 = (b * 4 + h) * 2; const int pos0 = c + 4, pos1 = 131 - c;
    const bf16_t* s0p = DS + ((size_t)(seq0 + 0) * NPOS + pos0) * 8192; const bf16_t* s1p = DS + ((size_t)(seq0 + 1) * NPOS + pos1) * 8192;
    const bf16_t* QKT = (const bf16_t*)(ws + WS_H) + ((size_t)((b * 4 + h) * 128 + c) * 4) * 4096;
#pragma unroll
    for (int i = 0; i < 2; ++i) { const int id = tid + NTHR * i, row = id >> 4, c16 = id & 15;
        *(LAS u32x4*)(VI + row * 320 + c16 * 16) = *(const u32x4*)(P + (size_t)(row0 + row) * PW + C_GV + h * 128 + c16 * 8);
        *(LAS u32x4*)(SI0 + row * 320 + c16 * 16) = *(const u32x4*)(s0p + row * 128 + c16 * 8);
        *(LAS u32x4*)(SI1 + row * 320 + c16 * 16) = *(const u32x4*)(s1p + row * 128 + c16 * 8); }
    { const int row = tid >> 3, c8 = tid & 7;
      *(LAS u32x4*)(QI0 + row * 144 + c8 * 16) = *(const u32x4*)(QKT + 0 * 4096 + row * 64 + c8 * 8);
      *(LAS u32x4*)(KI0 + row * 144 + c8 * 16) = *(const u32x4*)(QKT + 1 * 4096 + row * 64 + c8 * 8);
      *(LAS u32x4*)(QI1 + row * 144 + c8 * 16) = *(const u32x4*)(QKT + 2 * 4096 + row * 64 + c8 * 8);
      *(LAS u32x4*)(KI1 + row * 144 + c8 * 16) = *(const u32x4*)(QKT + 3 * 4096 + row * 64 + c8 * 8); }
    const int r = lane & 31, hh = lane >> 5, q = (lane & 15) >> 2, pc = lane & 3, blk = (lane >> 4) & 1;
    const int it = wave & 1, dvt = wave >> 1;
    const size_t rowg = (size_t)(row0 + 32 * it + r);
    u32x2 rgate[4];
#pragma unroll
    for (int gi = 0; gi < 4; ++gi) rgate[gi] = *(const u32x2*)(P + rowg * PW + C_GR + h * 128 + 32 * dvt + 8 * gi + 4 * hh);
    __syncthreads();
    f32x16 O = {};
#pragma unroll
    for (int dir = 0; dir < 2; ++dir) {
        const LAS unsigned char* QI = dir == 0 ? QI0 : QI1; const LAS unsigned char* KI = dir == 0 ? KI0 : KI1; const LAS unsigned char* SI = dir == 0 ? SI0 : SI1;
        bf16x8 qfr[4];
#pragma unroll
        for (int ks = 0; ks < 4; ++ks) qfr[ks] = *(const LAS bf16x8*)(QI + (32 * it + r) * 144 + (16 * ks + 8 * hh) * 2);
#pragma unroll
        for (int jt = 0; jt < 2; ++jt) {
            if (dir == 0 ? (jt > it) : (jt < it)) continue;
            f32x16 X = {};
#pragma unroll
            for (int ks = 0; ks < 4; ++ks) { const bf16x8 a = *(const LAS bf16x8*)(KI + (32 * jt + r) * 144 + (16 * ks + 8 * hh) * 2); X = MFMA32(a, qfr[ks], X); }
            if (jt == it) {
#pragma unroll
                for (int i = 0; i < 16; ++i) { const int jl = crow(i, hh); const bool keep = dir == 0 ? (jl <= r) : (jl >= r); X[i] = keep ? X[i] : 0.f; }
            }
            u32x4 w0, w1; w0.x = pk_bf16(X[0], X[1]); w0.y = pk_bf16(X[2], X[3]); w0.z = pk_bf16(X[4], X[5]); w0.w = pk_bf16(X[6], X[7]);
            w1.x = pk_bf16(X[8], X[9]); w1.y = pk_bf16(X[10], X[11]); w1.z = pk_bf16(X[12], X[13]); w1.w = pk_bf16(X[14], X[15]);
            const bf16x8 pb0 = __builtin_bit_cast(bf16x8, w0), pb1 = __builtin_bit_cast(bf16x8, w1);
            const bf16x8 v0 = tr_frag(VI + (32 * jt + 4 * hh + q) * 320 + dvt * 64 + 32 * blk + 8 * pc, 8 * 320);
            const bf16x8 v1 = tr_frag(VI + (32 * jt + 16 + 4 * hh + q) * 320 + dvt * 64 + 32 * blk + 8 * pc, 8 * 320);
            O = MFMA32(v0, pb0, O); O = MFMA32(v1, pb1, O);
        }
#pragma unroll
        for (int ks = 0; ks < 4; ++ks) { const bf16x8 a3 = tr_frag(SI + (16 * ks + 8 * hh + q) * 320 + dvt * 64 + 32 * blk + 8 * pc, 4 * 320); O = MFMA32(a3, qfr[ks], O); }
    }
    float ss = 0.f;
#pragma unroll
    for (int i = 0; i < 16; ++i) ss += O[i] * O[i];
    ss += __shfl_xor(ss, 32);
    if (lane < 32) RED[(it * 4 + dvt) * 32 + r] = ss;
    __syncthreads();
    const float tot = (RED[(it * 4 + 0) * 32 + r] + RED[(it * 4 + 1) * 32 + r]) + (RED[(it * 4 + 2) * 32 + r] + RED[(it * 4 + 3) * 32 + r]);
    const float rs = rsqrtf(tot * (1.0f / 128.0f) + EPS);
#pragma unroll
    for (int gi = 0; gi < 4; ++gi) { const int dv0 = 32 * dvt + 8 * gi + 4 * hh;
        const u32x2 rr = rgate[gi]; const f32x4 gn = *(const f32x4*)(p.gla_norm_g + dv0);
        const float o0 = O[4 * gi] * rs * gn[0] * silu_f(bf_lo(rr.x)), o1 = O[4 * gi + 1] * rs * gn[1] * silu_f(bf_hi(rr.x));
        const float o2 = O[4 * gi + 2] * rs * gn[2] * silu_f(bf_lo(rr.y)), o3 = O[4 * gi + 3] * rs * gn[3] * silu_f(bf_hi(rr.y));
        u32x2 w; w.x = pk_bf16(o0, o1); w.y = pk_bf16(o2, o3); *(u32x2*)(MIX + rowg * D + h * 128 + dv0) = w; }
    __syncthreads();
}

constexpr int ATT_KB = 64 * 272, ATT_VB = 64 * 320, ATT_BUF = ATT_KB + ATT_VB;
DI void att_stage(f32x16& Snew, const f32x16& Sold, const LAS unsigned char* Kp, const LAS unsigned char* Vp, const bf16x8 (&qf)[4], const float negM, f32x16 (&acc)[4], float& lsum) {
    float pe[16];
#pragma unroll
    for (int i = 0; i < 16; ++i) Snew[i] = negM;
    { const bf16x8 a = *(const LAS bf16x8*)(Kp); Snew = MFMA32(a, qf[0], Snew); }
#pragma unroll
    for (int i = 0; i < 4; ++i) pe[i] = __builtin_amdgcn_exp2f(Sold[i]);
    { const bf16x8 a = *(const LAS bf16x8*)(Kp + 32); Snew = MFMA32(a, qf[1], Snew); }
#pragma unroll
    for (int i = 4; i < 8; ++i) pe[i] = __builtin_amdgcn_exp2f(Sold[i]);
    { const bf16x8 a = *(const LAS bf16x8*)(Kp + 64); Snew = MFMA32(a, qf[2], Snew); }
#pragma unroll
    for (int i = 8; i < 12; ++i) pe[i] = __builtin_amdgcn_exp2f(Sold[i]);
    { const bf16x8 a = *(const LAS bf16x8*)(Kp + 96); Snew = MFMA32(a, qf[3], Snew); }
#pragma unroll
    for (int i = 12; i < 16; ++i) pe[i] = __builtin_amdgcn_exp2f(Sold[i]);
    lsum += ((pe[0] + pe[1]) + (pe[2] + pe[3])) + ((pe[4] + pe[5]) + (pe[6] + pe[7])) + ((pe[8] + pe[9]) + (pe[10] + pe[11])) + ((pe[12] + pe[13]) + (pe[14] + pe[15]));
    u32x4 w0, w1; w0.x = pk_bf16(pe[0], pe[1]); w0.y = pk_bf16(pe[2], pe[3]); w0.z = pk_bf16(pe[4], pe[5]); w0.w = pk_bf16(pe[6], pe[7]);
    w1.x = pk_bf16(pe[8], pe[9]); w1.y = pk_bf16(pe[10], pe[11]); w1.z = pk_bf16(pe[12], pe[13]); w1.w = pk_bf16(pe[14], pe[15]);
    const bf16x8 pb0 = __builtin_bit_cast(bf16x8, w0), pb1 = __builtin_bit_cast(bf16x8, w1);
#pragma unroll
    for (int t = 0; t < 4; ++t) { const bf16x8 v0 = tr_frag(Vp + t * 64, 8 * 320); acc[t] = MFMA32(v0, pb0, acc[t]); }
#pragma unroll
    for (int t = 0; t < 4; ++t) { const bf16x8 v1 = tr_frag(Vp + 16 * 320 + t * 64, 8 * 320); acc[t] = MFMA32(v1, pb1, acc[t]); }
}
struct BScan { unsigned* base; const float* dec; float s0, s1; unsigned raw; float d; int step; };
DI void bscan_init(const Params& p, BScan& B) {
    unsigned char* ws = p.ws; const int e = blockIdx.x * NTHR + my_tid();
    const int seq = e >> 12, dk = (e >> 6) & 63, dvp = e & 63;
    B.base = (unsigned*)(ws + WS_DS) + (size_t)seq * NPOS * 4096 + dk * 64 + dvp; B.dec = (const float*)(ws + WS_DEC) + (size_t)seq * NPOS * 64 + dk;
    B.s0 = 0.f; B.s1 = 0.f; B.raw = 0u; B.d = 0.f; B.step = 0;
}
DI void bscan_top(BScan& B) {
    if ((B.step & 3) == 0) { const int pp = B.step >> 2; B.raw = B.base[(size_t)pp * 4096]; B.d = B.dec[pp * 64]; B.base[(size_t)pp * 4096] = pk_bf16(B.s0, B.s1); }
}
DI void bscan_bottom(BScan& B) {
    if ((B.step & 3) == 0) { B.s0 = B.d * B.s0 + bf_lo(B.raw); B.s1 = B.d * B.s1 + bf_hi(B.raw); }
    ++B.step;
}
template <bool FUSEB>
DI void attn_unit(const Params& p, LAS unsigned char* lds, int b, int h, int qblk, float Mshift, float lam, int trot, BScan& BS) {
    unsigned char* ws = p.ws; const int tid = my_tid(), lane = tid & 63, wave = __builtin_amdgcn_readfirstlane(tid >> 6);
    const bf16_t* P = (const bf16_t*)(ws + WS_P); bf16_t* MIX = (bf16_t*)(ws + WS_MIX);
    const int r = lane & 31, hh = lane >> 5, q = (lane & 15) >> 2, pc = lane & 3, blk = (lane >> 4) & 1;
    const int comp = wave >> 2, wq = wave & 3;
    const size_t qrow = (size_t)b * SEQ + qblk * 128 + wq * 32 + r;
    bf16x8 qf[4];
    {
        const f32x2* tab = (const f32x2*)(ws + WS_ROPE);
        u32x4 qraw[4];
#pragma unroll
        for (int ks = 0; ks < 4; ++ks) qraw[ks] = *(const u32x4*)(P + qrow * PW + C_DQ + h * 128 + comp * 64 + ks * 16 + hh * 8);
        float y[4][8]; float ss = 0.f;
#pragma unroll
        for (int ks = 0; ks < 4; ++ks) { y[ks][0] = bf_lo(qraw[ks].x); y[ks][1] = bf_hi(qraw[ks].x); y[ks][2] = bf_lo(qraw[ks].y); y[ks][3] = bf_hi(qraw[ks].y);
            y[ks][4] = bf_lo(qraw[ks].z); y[ks][5] = bf_hi(qraw[ks].z); y[ks][6] = bf_lo(qraw[ks].w); y[ks][7] = bf_hi(qraw[ks].w);
#pragma unroll
            for (int j = 0; j < 8; ++j) ss += y[ks][j] * y[ks][j]; }
        ss += __shfl_xor(ss, 32);
        const float rs = rsqrtf(ss * (1.0f / 64.0f) + EPS) * (0.125f * 1.4426950409f);
#pragma unroll
        for (int ks = 0; ks < 4; ++ks)
#pragma unroll
            for (int j = 0; j < 8; ++j) y[ks][j] *= rs * p.q_norm_g[ks * 16 + hh * 8 + j];
        const int tq = qblk * 128 + wq * 32 + r;
#pragma unroll
        for (int ax = 0; ax < 2; ++ax) { const int pos = ax ? (tq & 63) : (tq >> 6);
#pragma unroll
            for (int j = 0; j < 8; ++j) { const f32x2 cs = tab[pos * 16 + hh * 8 + j]; const float x1 = y[2 * ax][j], x2 = y[2 * ax + 1][j];
                y[2 * ax][j] = x1 * cs.x - x2 * cs.y; y[2 * ax + 1][j] = x2 * cs.x + x1 * cs.y; } }
#pragma unroll
        for (int ks = 0; ks < 4; ++ks) { u32x4 w; w.x = pk_bf16(y[ks][0], y[ks][1]); w.y = pk_bf16(y[ks][2], y[ks][3]); w.z = pk_bf16(y[ks][4], y[ks][5]); w.w = pk_bf16(y[ks][6], y[ks][7]);
            qf[ks] = __builtin_bit_cast(bf16x8, w); }
    }
    f32x16 acc[4];
#pragma unroll
    for (int t = 0; t < 4; ++t)
#pragma unroll
        for (int i = 0; i < 16; ++i) acc[t][i] = 0.f;
    const float negM = -Mshift;
    float lsum = 0.f;
    const int ldr = tid >> 4, ldc = tid & 15;
    const int koff = (r) * 272 + comp * 128 + hh * 16;
    const int voff = ATT_KB + (4 * hh + q) * 320 + 32 * blk + 8 * pc;
    u32x4 kreg[2], vreg[2];
#define ATT_GROW(kt, row) ((kt) < 4 ? (size_t)(NLAT + b * CTXL + (kt) * 64 + (row)) : (size_t)(b * SEQ + ((kt) - 4) * 64 + (row)))
#define ATT_LOAD(kr, vr, kt0) do { int kt_ = (kt0) + trot; kt_ = kt_ >= NPOS ? kt_ - NPOS : kt_; _Pragma("unroll") for (int i_ = 0; i_ < 2; ++i_) { const bf16_t* g_ = P + ATT_GROW(kt_, ldr + 32 * i_) * PW + h * 128 + ldc * 8; \
        kr[i_] = *(const u32x4*)(g_ + C_DK); vr[i_] = *(const u32x4*)(g_ + C_DV); } } while (0)
#define ATT_STORE(kr, vr, bufp) do { _Pragma("unroll") for (int i_ = 0; i_ < 2; ++i_) { *(LAS u32x4*)((bufp) + (ldr + 32 * i_) * 272 + ldc * 16) = kr[i_]; \
        *(LAS u32x4*)((bufp) + ATT_KB + (ldr + 32 * i_) * 320 + ldc * 16) = vr[i_]; } } while (0)
    for (int i = tid; i < ATT_VB / 16; i += NTHR) *(LAS u32x4*)(lds + 2 * ATT_BUF + ATT_KB + i * 16) = (u32x4){0u, 0u, 0u, 0u};
    ATT_LOAD(kreg, vreg, 0); ATT_STORE(kreg, vreg, lds);
    __syncthreads();
    f32x16 S0, S1;
#pragma unroll
    for (int i = 0; i < 16; ++i) { S1[i] = -1.0e30f; S0[i] = 0.f; }
    int cur = 0, prv = 2, nxt = 1;
    for (int kt = 0; kt < NPOS; ++kt) {
        const LAS unsigned char* Bc = lds + cur * ATT_BUF; const LAS unsigned char* Bp = lds + prv * ATT_BUF;
        if (kt + 1 < NPOS) ATT_LOAD(kreg, vreg, kt + 1);
        if (FUSEB) bscan_top(BS);
        __builtin_amdgcn_sched_barrier(0);
        att_stage(S0, S1, Bc + koff, Bp + voff + 32 * 320, qf, negM, acc, lsum);
        att_stage(S1, S0, Bc + koff + 32 * 272, Bc + voff, qf, negM, acc, lsum);
        __builtin_amdgcn_sched_barrier(0);
        if (kt + 1 < NPOS) ATT_STORE(kreg, vreg, lds + nxt * ATT_BUF);
        if (FUSEB) bscan_bottom(BS);
        __syncthreads();
        { const int t_ = prv; prv = cur; cur = nxt; nxt = t_; }
    }
#undef ATT_GROW
#undef ATT_LOAD
#undef ATT_STORE
    {
        const LAS unsigned char* Vp = lds + prv * ATT_BUF + voff + 32 * 320;
        float pe[16];
#pragma unroll
        for (int i = 0; i < 16; ++i) { pe[i] = __builtin_amdgcn_exp2f(S1[i]); lsum += pe[i]; }
        u32x4 w0, w1; w0.x = pk_bf16(pe[0], pe[1]); w0.y = pk_bf16(pe[2], pe[3]); w0.z = pk_bf16(pe[4], pe[5]); w0.w = pk_bf16(pe[6], pe[7]);
        w1.x = pk_bf16(pe[8], pe[9]); w1.y = pk_bf16(pe[10], pe[11]); w1.z = pk_bf16(pe[12], pe[13]); w1.w = pk_bf16(pe[14], pe[15]);
        const bf16x8 pb0 = __builtin_bit_cast(bf16x8, w0), pb1 = __builtin_bit_cast(bf16x8, w1);
#pragma unroll
        for (int t = 0; t < 4; ++t) { const bf16x8 v0 = tr_frag(Vp + t * 64, 8 * 320); const bf16x8 v1 = tr_frag(Vp + 16 * 320 + t * 64, 8 * 320);
            acc[t] = MFMA32(v0, pb0, acc[t]); acc[t] = MFMA32(v1, pb1, acc[t]); }
    }
    __syncthreads();
    const float l = lsum + __shfl_xor(lsum, 32);
    const float sc = (comp ? lam : 1.0f) / l;
#pragma unroll
    for (int t = 0; t < 4; ++t)
#pragma unroll
        for (int i = 0; i < 16; ++i) acc[t][i] *= sc;
    LAS float* X = (LAS float*)lds + wq * 4096;
    if (comp == 1) {
#pragma unroll
        for (int t = 0; t < 4; ++t)
#pragma unroll
            for (int i = 0; i < 16; ++i) X[(t * 16 + i) * 64 + lane] = acc[t][i];
    }
    __syncthreads();
    if (comp == 0) {
        float ss = 0.f;
#pragma unroll
        for (int t = 0; t < 4; ++t)
#pragma unroll
            for (int i = 0; i < 16; ++i) { acc[t][i] -= X[(t * 16 + i) * 64 + lane]; ss += acc[t][i] * acc[t][i]; }
        ss += __shfl_xor(ss, 32);
        const float rs = rsqrtf(ss * (1.0f / 128.0f) + EPS) * 0.8f;
#pragma unroll
        for (int t = 0; t < 4; ++t)
#pragma unroll
            for (int gi = 0; gi < 4; ++gi) { const int dv0 = 32 * t + 8 * gi + 4 * hh; const f32x4 gn = *(const f32x4*)(p.diff_norm_g + dv0);
                u32x2 w; w.x = pk_bf16(acc[t][4 * gi] * rs * gn[0], acc[t][4 * gi + 1] * rs * gn[1]); w.y = pk_bf16(acc[t][4 * gi + 2] * rs * gn[2], acc[t][4 * gi + 3] * rs * gn[3]);
                *(u32x2*)(MIX + qrow * D + 512 + h * 128 + dv0) = w; }
    }
    __syncthreads();
}

#define XB_TMO      128
#define XB_XCNT(j)  (256  + 64 * (j))
#define XB_XSUB(j)  (1280 + 64 * (j))
#define XB_XGEN(j)  (2304 + 64 * (j))
#define XB_TOP      3328
#define XB_TOPGEN   3392
#define XCD_BAR_WORDS 3456
#define XB_SPIN_CAP (1u << 22)
DI unsigned xb_ld(unsigned* p)              { return __hip_atomic_load(p, __ATOMIC_RELAXED, __HIP_MEMORY_SCOPE_AGENT); }
DI unsigned xb_add(unsigned* p, unsigned v) { return __hip_atomic_fetch_add(p, v, __ATOMIC_RELAXED, __HIP_MEMORY_SCOPE_AGENT); }
DI unsigned xb_xcc_id() { return (unsigned)__builtin_amdgcn_s_getreg((3 << 11) | 20) & 0xFu; }
#define XB_SPIN(cond, bar) do { unsigned _sp = 0; while (cond) { __builtin_amdgcn_s_sleep(1); \
    if ((++_sp & 255u) == 0u) { if (xb_ld(&(bar)[XB_TMO])) break; if (_sp > XB_SPIN_CAP) { atomicAdd(&(bar)[XB_TMO], 1u); break; } } } } while (0)
struct XcdBarrier { unsigned* bar; unsigned x; volatile LAS unsigned* st; };
DI XcdBarrier xcd_barrier_post(unsigned* bar, volatile LAS unsigned* st) {
    XcdBarrier b; b.bar = bar; b.x = xb_xcc_id(); b.st = st;
    if (threadIdx.x == 0) (void)xb_add(&bar[XB_XCNT(b.x)], 1u);
    return b;
}
DI void xcd_barrier_complete(unsigned* bar, unsigned x, unsigned& nloc, unsigned& nx) {
    const unsigned G = gridDim.x * gridDim.y * gridDim.z;
    unsigned sum, cnt, mine, sp = 0u;
    for (;;) {
        sum = 0u; cnt = 0u; mine = 0u;
#pragma unroll
        for (unsigned j = 0; j < 16; ++j) { const unsigned c = xb_ld(&bar[XB_XCNT(j)]); sum += c; cnt += (c > 0u) ? 1u : 0u; mine = (j == x) ? c : mine; }
        if (sum == G) break;
        __builtin_amdgcn_s_sleep(1);
        if ((++sp & 255u) == 0u) { if (xb_ld(&bar[XB_TMO])) break; if (sp > XB_SPIN_CAP) { atomicAdd(&bar[XB_TMO], 1u); break; } }
    }
    nloc = mine > 0u ? mine : 1u; nx = cnt > 0u ? cnt : 1u;
}
DI void xcd_barrier(const XcdBarrier& b) {
    asm volatile("s_waitcnt vmcnt(0)" ::: "memory");
    __syncthreads();
    if (threadIdx.x == 0) {
        unsigned* bar = b.bar;
        __builtin_amdgcn_s_waitcnt(0);
        unsigned nloc = b.st[0], nx = b.st[1];
        if (nloc == 0u) { xcd_barrier_complete(bar, b.x, nloc, nx); b.st[0] = nloc; b.st[1] = nx; }
        const unsigned old = xb_add(&bar[XB_XSUB(b.x)], 1u);
        const unsigned gen = old / nloc;
        if (old + 1u == (gen + 1u) * nloc) {
            __builtin_amdgcn_fence(__ATOMIC_RELEASE, "agent");
            asm volatile("s_waitcnt vmcnt(0)" ::: "memory");
            const unsigned og = xb_add(&bar[XB_TOP], 1u);
            const unsigned tg = og / nx;
            if (og + 1u == (tg + 1u) * nx) xb_add(&bar[XB_TOPGEN], 1u);
            else XB_SPIN(xb_ld(&bar[XB_TOPGEN]) == tg, bar);
            __builtin_amdgcn_fence(__ATOMIC_ACQUIRE, "agent");
            xb_add(&bar[XB_XGEN(b.x)], 1u);
            asm volatile("s_waitcnt vmcnt(0)" ::: "memory");
        } else {
            XB_SPIN(xb_ld(&bar[XB_XGEN(b.x)]) == gen, bar);
            __builtin_amdgcn_fence(__ATOMIC_ACQUIRE, "agent");
            asm volatile("s_waitcnt vmcnt(0)" ::: "memory");
        }
    }
    __syncthreads();
}

__global__ void __launch_bounds__(NTHR, 2) mega_fwd(Params p) {
    extern __shared__ __attribute__((aligned(16))) unsigned char lds_raw[];
    LAS unsigned char* lds = (LAS unsigned char*)lds_raw;
    cg::grid_group grid = cg::this_grid();
    unsigned char* ws = p.ws;
    const int lo = p.ph_lo, hi = p.ph_hi;
    const int G = gridDim.x, bid = blockIdx.x;
    if (lo < 0) grid.sync();
    volatile LAS unsigned* xbw = (volatile LAS unsigned*)(lds + LDS_MAIN);
    if (threadIdx.x < 4) xbw[threadIdx.x] = 0u;
    __syncthreads();
    XcdBarrier xbar = xcd_barrier_post((unsigned*)(ws + WS_BAR), xbw);
#define IN(k) (lo <= (k) && (k) < hi)
#define SEAM(k) do { if (IN(k) && IN((k) + 1)) xcd_barrier(xbar); } while (0)

    if (IN(0)) phase0(p, lds);
    SEAM(0);
    if (IN(1)) phase1(p);
    SEAM(1);
    if (IN(2)) {
        pg8::Gemm g{(const bf16_t*)(ws + WS_H), (const bf16_t*)(ws + WS_WIN), NT, PW, D}; pg8::StaticOrder S; S.init(NT, PW, G, bid);
        EpiInProj E{(bf16_t*)(ws + WS_P), (float*)(ws + WS_GD)};
        pg8::gemm_phase<EpiInProj, pg8::StaticOrder, true, true>(lds, g, S, E);
    }
    SEAM(2);
    if (IN(3)) {
        constexpr int N_QK = NT / 64, N_GA = 16 * NPOS;
        constexpr int N_PAIR = N_GA / 2;
        const int n_long = N_PAIR % G;
        if (n_long > 0 && n_long < G) { if (bid >= n_long) for (int it = bid - n_long; it < N_QK; it += G - n_long) qknorm_item(p, it); }
        else for (int it = bid; it < N_QK; it += G) qknorm_item(p, it);
        for (int j = bid; j < N_PAIR; j += G) gla_a_pair(p, lds, j, j + N_PAIR);
    }
    SEAM(3);
    if (IN(4)) {
        const float* ctl = (const float*)(ws + WS_CTL); const float lam = ctl[0], Msh = ctl[1];
        BScan BS;
        if (G == 256) {
            bscan_init(p, BS);
            const int xcd = bid & 7, cu = bid >> 3;
            for (int j = cu; j < 128; j += 32) { const int pair = xcd * 2 + (j >> 6), qb = j & 63; attn_unit<true>(p, lds, pair >> 2, pair & 3, qb, Msh, lam, 0, BS); }
        } else {
            gla_b(p); BS.base = nullptr; BS.dec = nullptr; BS.s0 = BS.s1 = BS.d = 0.f; BS.raw = 0u; BS.step = 0;
            for (int j = bid; j < 1024; j += G) attn_unit<false>(p, lds, j >> 8, (j >> 6) & 3, j & 63, Msh, lam, 0, BS);
        }
    }
    SEAM(4);
    if (IN(5)) {
        for (int j = bid; j < 16 * 128; j += G) gla_c_item(p, lds, j >> 9, (j >> 7) & 3, j & 127);
    }
    SEAM(5);
    if (IN(6)) {
        pg8::Gemm g{(const bf16_t*)(ws + WS_MIX), (const bf16_t*)(ws + WS_WOUT), NLAT, D, D}; pg8::StaticOrder S; S.init(NLAT, D, G, bid);
        EpiOutProj E{p.x, (const float*)(ws + WS_MOD), p.norm2_g, p.out, (bf16_t*)(ws + WS_H), (float*)(ws + WS_ROWSS)};
        pg8::gemm_phase<EpiOutProj, pg8::StaticOrder, true, true>(lds, g, S, E);
    }
    SEAM(6);
    if (IN(7)) {
        pg8::Gemm g{(const bf16_t*)(ws + WS_H), (const bf16_t*)(ws + WS_WF1), NLAT, FH2, D}; pg8::StaticOrder S; S.init(NLAT, FH2, G, bid);
        EpiFfnIn E{(const float*)(ws + WS_ROWSS), (const float*)(ws + WS_BIAS2), (bf16_t*)(ws + WS_P)};
        pg8::gemm_phase<EpiFfnIn, pg8::StaticOrder, true, true>(lds, g, S, E);
    }
    SEAM(7);
    if (IN(8)) {
        pg8::Gemm g{(const bf16_t*)(ws + WS_P), (const bf16_t*)(ws + WS_WF2), NLAT, D, FH}; pg8::StaticOrder S; S.init(NLAT, D, G, bid);
        EpiFfnOut E{(const float*)(ws + WS_MOD), p.out};
        pg8::gemm_phase<EpiFfnOut, pg8::StaticOrder, true, true>(lds, g, S, E);
    }
#undef IN
#undef SEAM
}

#ifndef MK_LAUNCHES
#define MK_LAUNCHES 1
#endif
extern "C" void kernel_launch(void* const* d_in, const int* in_sizes, int n_in, void* d_out, int out_size, void* d_ws, size_t ws_size, hipStream_t stream) {
    static int grid = 0;
    if (grid == 0) {
        if (n_in != 20 || ws_size < WS_END) { fprintf(stderr, "kernel_launch: unexpected n_in %d or ws_size %zu (< %zu)\n", n_in, ws_size, (size_t)WS_END); grid = -1; return; }
        int dev = 0, cus = 0, per_cu = 0;
        hipGetDevice(&dev); hipDeviceGetAttribute(&cus, hipDeviceAttributeMultiprocessorCount, dev);
        if (hipFuncSetAttribute((const void*)mega_fwd, hipFuncAttributeMaxDynamicSharedMemorySize, LDS_BYTES) != hipSuccess) { fprintf(stderr, "kernel_launch: hipFuncSetAttribute failed\n"); grid = -1; return; }
        if (hipOccupancyMaxActiveBlocksPerMultiprocessor(&per_cu, (const void*)mega_fwd, NTHR, LDS_BYTES) != hipSuccess || per_cu < 1) { fprintf(stderr, "kernel_launch: occupancy query failed (%d)\n", per_cu); per_cu = 1; }
        (void)hipGetLastError();
        grid = cus * per_cu;
    }
    if (grid < 0) return;
    if (hipMemsetAsync((char*)d_ws + WS_BAR, 0, XCD_BAR_WORDS * 4, stream) != hipSuccess) { fprintf(stderr, "kernel_launch: memset failed\n"); return; }
    Params p{};
    const float** pp = (const float**)&p;
    for (int i = 0; i < 20; ++i) pp[i] = (const float*)d_in[i];
    p.out = (float*)d_out; p.ws = (unsigned char*)d_ws;
#if MK_LAUNCHES == 1
    p.ph_lo = 0; p.ph_hi = 9;
    void* args[] = {&p};
    hipError_t e = hipLaunchCooperativeKernel((const void*)mega_fwd, dim3(grid), dim3(NTHR), args, LDS_BYTES, stream);
    if (e != hipSuccess) fprintf(stderr, "cooperative launch failed: %s (grid %d)\n", hipGetErrorString(e), grid);
#else
    for (int ph = 0; ph < 9; ++ph) { p.ph_lo = ph; p.ph_hi = ph + 1; hipLaunchKernelGGL(mega_fwd, dim3(grid), dim3(NTHR), LDS_BYTES, stream, p); }
#endif
}
```
